# Optimizing an MI355X kernel written in HIP

```python
import jax, jax.numpy as jnp
from jax import lax
import numpy as np

D_MODEL = 1024
BATCH = 16
SEQ = 2048
DEPTH = 1

D_PLE = 256
GLA_HEADS = 4
GLA_DK = 64
GLA_DV = 128
GLA_KEY = GLA_HEADS * GLA_DK
GLA_VAL = GLA_HEADS * GLA_DV
GLA_GATE_RANK = 16
GLA_GATE_NORM = 16.0
GLA_CHUNK = 64
POOL_WINDOWS = (2, 4, 8, 16)
POOL_GROUPS = len(POOL_WINDOWS)
POOL_WIDTH = D_MODEL - GLA_VAL
POOL_GC = POOL_WIDTH // POOL_GROUPS
D_MIX = GLA_VAL + POOL_WIDTH
D_IN = 2 * GLA_KEY + 2 * GLA_VAL + GLA_GATE_RANK + POOL_WIDTH
D_FF = ((8 * D_MODEL + 3 * 256 - 1) // (3 * 256)) * 256
EPS = 1e-6

kernel_name = "hybrid_gla_multiscale_pool_block"


def rmsnorm(x, g):
    xf = x.astype(jnp.float32)
    y = xf * lax.rsqrt(jnp.mean(xf * xf, axis=-1, keepdims=True) + EPS)
    return (y * g.astype(jnp.float32)).astype(x.dtype)


def gla_chunked(q, k, v, gk):
    B, T, H, DK = q.shape
    DV = v.shape[-1]
    C = GLA_CHUNK
    N = T // C

    def to_chunks(a):
        return a.astype(jnp.float32).reshape(B, N, C, H, a.shape[-1]).transpose(1, 0, 3, 2, 4)

    qc = to_chunks(q) * (DK ** -0.5)
    kc = to_chunks(k)
    vc = to_chunks(v)
    bc = jnp.cumsum(to_chunks(gk), axis=3)
    mask = jnp.tril(jnp.ones((C, C), dtype=bool))[:, :, None]

    def step(S, inp):
        qi, ki, vi, bi = inp
        diff = bi[:, :, :, None, :] - bi[:, :, None, :, :]
        decay = jnp.exp(jnp.where(mask, diff, -jnp.inf))
        attn = jnp.einsum('bhid,bhjd,bhijd->bhij', qi, ki, decay)
        o = jnp.einsum('bhij,bhjv->bhiv', attn, vi) + \
            jnp.einsum('bhid,bhdv->bhiv', qi * jnp.exp(bi), S)
        b_last = bi[:, :, -1, :]
        S = jnp.exp(b_last)[..., None] * S + jnp.einsum(
            'bhjd,bhjv->bhdv', ki * jnp.exp(b_last[:, :, None, :] - bi), vi)
        return S, o

    S0 = jnp.zeros((B, H, DK, DV), jnp.float32)
    _, o = lax.scan(step, S0, (qc, kc, vc, bc))
    return o.transpose(1, 0, 3, 2, 4).reshape(B, T, H, DV)


def multiscale_pool(u, w_pool, pool_scale):
    B, T, _ = u.shape
    uf = u.astype(jnp.float32).reshape(B, T, POOL_GROUPS, POOL_GC)
    cs = jnp.cumsum(uf, axis=1)
    t = jnp.arange(T)
    outs = []
    for gi, w in enumerate(POOL_WINDOWS):
        c = cs[:, :, gi]
        prev = jnp.pad(c, ((0, 0), (w, 0), (0, 0)))[:, :T]
        cnt = jnp.minimum(t + 1, w).astype(jnp.float32)[None, :, None]
        outs.append((c - prev) / cnt - uf[:, :, gi])
    pooled = jnp.stack(outs, axis=2)
    y = jnp.einsum('btgc,gcd->btgd', pooled, w_pool.astype(jnp.float32))
    y = y.reshape(B, T, POOL_WIDTH) * pool_scale.astype(jnp.float32)
    return y.astype(u.dtype)


def setup_inputs(seed: int = 0) -> dict:
    key = jax.random.key(seed)
    ks = jax.random.split(key, 20)
    f32 = jnp.float32

    def nrm(k, shape, fan_in):
        return jax.random.normal(k, shape, f32) * (fan_in ** -0.5)

    def gain(k, shape):
        return 1.0 + 0.02 * jax.random.normal(k, shape, f32)

    return {
        "x": jax.random.normal(ks[0], (BATCH, SEQ, D_MODEL), f32),
        "p": jax.random.normal(ks[1], (DEPTH, BATCH, SEQ, D_PLE), f32),
        "ln_mix": gain(ks[2], (DEPTH, D_MODEL)),
        "w_in": nrm(ks[3], (DEPTH, D_MODEL, D_IN), D_MODEL),
        "w_gate_lr": nrm(ks[4], (DEPTH, GLA_GATE_RANK, GLA_KEY), GLA_GATE_RANK),
        "b_gate": 0.1 * jax.random.normal(ks[5], (DEPTH, GLA_KEY), f32),
        "gla_norm": gain(ks[6], (DEPTH, GLA_DV)),
        "w_pool": nrm(ks[7], (DEPTH, POOL_GROUPS, POOL_GC, POOL_GC), POOL_GC),
        "pool_scale": gain(ks[8], (DEPTH, POOL_WIDTH)),
        "w_out": nrm(ks[9], (DEPTH, D_MIX, D_MODEL), D_MIX),
        "ln_ffn": gain(ks[10], (DEPTH, D_MODEL)),
        "w_ffn_gate": nrm(ks[11], (DEPTH, D_MODEL, D_FF), D_MODEL),
        "w_ffn_up": nrm(ks[12], (DEPTH, D_MODEL, D_FF), D_MODEL),
        "w_ffn_down": nrm(ks[13], (DEPTH, D_FF, D_MODEL), D_FF),
        "ln_ple": gain(ks[14], (DEPTH, D_MODEL)),
        "w_ple_gate": nrm(ks[15], (DEPTH, D_MODEL, D_MODEL), D_MODEL),
        "w_ple_proj": nrm(ks[16], (DEPTH, D_PLE, D_MODEL), D_PLE),
        "ln_final": gain(ks[17], (D_MODEL,)),
    }


def reference(x, p, ln_mix, w_in, w_gate_lr, b_gate, gla_norm, w_pool, pool_scale,
              w_out, ln_ffn, w_ffn_gate, w_ffn_up, w_ffn_down, ln_ple, w_ple_gate,
              w_ple_proj, ln_final):
    B, T, _ = x.shape
    splits = np.cumsum([GLA_KEY, GLA_KEY, GLA_VAL, GLA_VAL, GLA_GATE_RANK]).tolist()
    h = x
    for i in range(DEPTH):
        a = rmsnorm(h, ln_mix[i])
        z = a @ w_in[i]
        q, k, v, g_out, g_lr, u = jnp.split(z, splits, axis=-1)
        gk = jax.nn.log_sigmoid((g_lr @ w_gate_lr[i] + b_gate[i]).astype(jnp.float32)) / GLA_GATE_NORM
        o = gla_chunked(q.reshape(B, T, GLA_HEADS, GLA_DK),
                        k.reshape(B, T, GLA_HEADS, GLA_DK),
                        v.reshape(B, T, GLA_HEADS, GLA_DV),
                        gk.reshape(B, T, GLA_HEADS, GLA_DK))
        o = rmsnorm(o, gla_norm[i]).reshape(B, T, GLA_VAL).astype(h.dtype)
        o = o * jax.nn.silu(g_out)
        y_pool = multiscale_pool(u, w_pool[i], pool_scale[i])
        mix = jnp.concatenate([o, y_pool], axis=-1) @ w_out[i]
        h = h + mix
        f = rmsnorm(h, ln_ffn[i])
        h = h + (jax.nn.silu(f @ w_ffn_gate[i]) * (f @ w_ffn_up[i])) @ w_ffn_down[i]
        e = rmsnorm(h, ln_ple[i])
        h = h + jax.nn.sigmoid(e @ w_ple_gate[i]) * (p[i].astype(h.dtype) @ w_ple_proj[i])
    return rmsnorm(h, ln_final)
```

```cpp
#include <hip/hip_runtime.h>
#include <cstdio>
#include <cstdint>

namespace nv {
constexpr int D = 1024, BATCH = 16, SEQ = 2048, M = BATCH * SEQ;
constexpr int DPLE = 256, H = 4, DK = 64, DV = 128, KEY = 256, VAL = 512, RANK = 16, POOLW = 512, GC = 128;
constexpr int DIN = 2 * KEY + 2 * VAL + RANK + POOLW;
constexpr int FF = 2816;
constexpr float EPS = 1e-6f;
constexpr int ZQ = 0, ZK = 256, ZV = 512, ZG = 1024, ZLR = 1536, ZU = 1552;

template <int MODE>
__global__ void __launch_bounds__(256) gemm_k(const float* __restrict__ A, int lda, const float* __restrict__ B, int ldb, float* C, int ldc,
                                               int Mr, int N, int K, const float* X, int ldx, const float* Y, int ldy, const float* cs) {
    __shared__ float As[16][68];
    __shared__ float Bs[16][68];
    const int tid = threadIdx.x, tx = tid & 15, ty = tid >> 4;
    const int m0 = blockIdx.y * 64, n0 = blockIdx.x * 64;
    float acc[4][4] = {};
    const int ar = tid >> 2, ak = (tid & 3) * 4;
    const int bk = tid >> 4, bn = (tid & 15) * 4;
    for (int k0 = 0; k0 < K; k0 += 16) {
        float4 av = *(const float4*)(A + (size_t)(m0 + ar) * lda + k0 + ak);
        float4 bv = make_float4(0.f, 0.f, 0.f, 0.f);
        if (n0 + bn < N) bv = *(const float4*)(B + (size_t)(k0 + bk) * ldb + n0 + bn);
        As[ak + 0][ar] = av.x; As[ak + 1][ar] = av.y; As[ak + 2][ar] = av.z; As[ak + 3][ar] = av.w;
        *(float4*)&Bs[bk][bn] = bv;
        __syncthreads();
#pragma unroll
        for (int kk = 0; kk < 16; ++kk) {
            float a[4], b[4];
#pragma unroll
            for (int i = 0; i < 4; ++i) a[i] = As[kk][ty * 4 + i];
#pragma unroll
            for (int j = 0; j < 4; ++j) b[j] = Bs[kk][tx * 4 + j];
#pragma unroll
            for (int i = 0; i < 4; ++i)
#pragma unroll
                for (int j = 0; j < 4; ++j) acc[i][j] = fmaf(a[i], b[j], acc[i][j]);
        }
        __syncthreads();
    }
#pragma unroll
    for (int i = 0; i < 4; ++i) {
        const int r = m0 + ty * 4 + i;
#pragma unroll
        for (int j = 0; j < 4; ++j) {
            const int c = n0 + tx * 4 + j;
            if (c < N) {
                float v = acc[i][j];
                if (MODE == 1) v = X[(size_t)r * ldx + c] + v;
                if (MODE == 2) { const float g = X[(size_t)r * ldx + c]; v = (g / (1.f + expf(-g))) * v; }
                if (MODE == 3) { const float g = X[(size_t)r * ldx + c]; v = Y[(size_t)r * ldy + c] + (1.f / (1.f + expf(-g))) * v; }
                if (MODE == 4) v = v * cs[c];
                C[(size_t)r * ldc + c] = v;
            }
        }
    }
}

__global__ void __launch_bounds__(256) rmsnorm_k(const float* x, int ldx, const float* __restrict__ g, float* out, int ldo, int rows, int W, int segs,
                                                  const float* gt, int ldg) {
    const int wave = (blockIdx.x * 256 + threadIdx.x) >> 6, lane = threadIdx.x & 63;
    if (wave >= rows * segs) return;
    const int row = wave / segs, seg = wave % segs;
    const float* xr = x + (size_t)row * ldx + seg * W;
    float s = 0.f;
    for (int c = lane; c < W; c += 64) { const float v = xr[c]; s += v * v; }
#pragma unroll
    for (int o = 1; o < 64; o <<= 1) s += __shfl_xor(s, o);
    const float r = 1.0f / sqrtf(s / (float)W + EPS);
    float* orow = out + (size_t)row * ldo + seg * W;
    for (int c = lane; c < W; c += 64) {
        float v = xr[c] * r * g[c];
        if (gt) { const float t = gt[(size_t)row * ldg + seg * W + c]; v *= t / (1.f + expf(-t)); }
        orow[c] = v;
    }
}

__global__ void gk_k(const float* z, const float* __restrict__ wg, const float* __restrict__ bg, float* gk, int rows) {
    const int idx = blockIdx.x * 256 + threadIdx.x;
    if (idx >= rows * KEY) return;
    const int m = idx / KEY, c = idx % KEY;
    float s = bg[c];
    for (int r = 0; r < RANK; ++r) s = fmaf(z[(size_t)m * DIN + ZLR + r], wg[r * KEY + c], s);
    const float ls = fminf(s, 0.f) - log1pf(expf(-fabsf(s)));
    gk[idx] = ls * (1.0f / 16.0f);
}

__global__ void __launch_bounds__(128) gla_k(const float* z, const float* gk, float* o, int nb) {
    const int b = blockIdx.x / H, h = blockIdx.x % H, v = threadIdx.x;
    __shared__ float sq[DK], sk[DK], sa[DK];
    float S[DK];
#pragma unroll
    for (int d = 0; d < DK; ++d) S[d] = 0.f;
    for (int t = 0; t < SEQ; ++t) {
        const size_t m = (size_t)b * SEQ + t;
        if (v < DK) { sq[v] = z[m * DIN + ZQ + h * DK + v] * 0.125f; sk[v] = z[m * DIN + ZK + h * DK + v]; sa[v] = expf(gk[m * KEY + h * DK + v]); }
        __syncthreads();
        const float vv = z[m * DIN + ZV + h * DV + v];
        float acc = 0.f;
#pragma unroll
        for (int d = 0; d < DK; ++d) { S[d] = fmaf(sa[d], S[d], sk[d] * vv); acc = fmaf(sq[d], S[d], acc); }
        o[m * VAL + h * DV + v] = acc;
        __syncthreads();
    }
}

__global__ void pool_k(const float* z, float* pooled, int rows) {
    const int idx = blockIdx.x * 256 + threadIdx.x;
    if (idx >= rows * POOLW) return;
    const int m = idx / POOLW, c = idx % POOLW, t = m % SEQ, g = c / GC;
    const int w = 2 << g;
    const int cnt = (t + 1 < w) ? (t + 1) : w;
    float s = 0.f;
    for (int j = 0; j < cnt; ++j) s += z[(size_t)(m - j) * DIN + ZU + c];
    pooled[idx] = s / (float)cnt - z[(size_t)m * DIN + ZU + c];
}
}

using namespace nv;

template <int MODE>
static void gemm(hipStream_t st, const float* A, int lda, const float* B, int ldb, float* C, int ldc, int Mr, int N, int K,
                 const float* X = nullptr, int ldx = 0, const float* Y = nullptr, int ldy = 0, const float* cs = nullptr) {
    dim3 grid((N + 63) / 64, Mr / 64);
    hipLaunchKernelGGL(gemm_k<MODE>, grid, dim3(256), 0, st, A, lda, B, ldb, C, ldc, Mr, N, K, X, ldx, Y, ldy, cs);
}
static void rmsnorm(hipStream_t st, const float* x, int ldx, const float* g, float* out, int ldo, int rows, int W, int segs, const float* gt = nullptr, int ldg = 0) {
    const int waves = rows * segs;
    hipLaunchKernelGGL(rmsnorm_k, dim3((waves + 3) / 4), dim3(256), 0, st, x, ldx, g, out, ldo, rows, W, segs, gt, ldg);
}

extern "C" void kernel_launch(void* const* d_in, const int* in_sizes, int n_in, void* d_out, int out_size, void* d_ws, size_t ws_size, hipStream_t stream) {
    const float* x = (const float*)d_in[0];
    const float* p = (const float*)d_in[1];
    const float* ln_mix = (const float*)d_in[2];
    const float* w_in = (const float*)d_in[3];
    const float* w_gate_lr = (const float*)d_in[4];
    const float* b_gate = (const float*)d_in[5];
    const float* gla_norm = (const float*)d_in[6];
    const float* w_pool = (const float*)d_in[7];
    const float* pool_scale = (const float*)d_in[8];
    const float* w_out = (const float*)d_in[9];
    const float* ln_ffn = (const float*)d_in[10];
    const float* w_ffn_gate = (const float*)d_in[11];
    const float* w_ffn_up = (const float*)d_in[12];
    const float* w_ffn_down = (const float*)d_in[13];
    const float* ln_ple = (const float*)d_in[14];
    const float* w_ple_gate = (const float*)d_in[15];
    const float* w_ple_proj = (const float*)d_in[16];
    const float* ln_final = (const float*)d_in[17];
    float* h = (float*)d_out;
    float* ws = (float*)d_ws;

    const int MH = M / 2;
    float* a = ws;
    float* z = a + (size_t)MH * D;
    float* gk = z + (size_t)MH * DIN;
    float* o = gk + (size_t)MH * KEY;
    float* pooled = o + (size_t)MH * VAL;
    float* mixin = pooled + (size_t)MH * POOLW;
    for (int hf = 0; hf < 2; ++hf) {
        const float* xh = x + (size_t)hf * MH * D;
        float* hh = h + (size_t)hf * MH * D;
        rmsnorm(stream, xh, D, ln_mix, a, D, MH, D, 1);
        gemm<0>(stream, a, D, w_in, DIN, z, DIN, MH, DIN, D);
        hipLaunchKernelGGL(gk_k, dim3((MH * KEY + 255) / 256), dim3(256), 0, stream, z, w_gate_lr, b_gate, gk, MH);
        hipLaunchKernelGGL(gla_k, dim3((BATCH / 2) * H), dim3(128), 0, stream, z, gk, o, BATCH / 2);
        rmsnorm(stream, o, VAL, gla_norm, mixin, D, MH, DV, H, z + ZG, DIN);
        hipLaunchKernelGGL(pool_k, dim3((MH * POOLW + 255) / 256), dim3(256), 0, stream, z, pooled, MH);
        for (int g = 0; g < 4; ++g)
            gemm<4>(stream, pooled + g * GC, POOLW, w_pool + (size_t)g * GC * GC, GC, mixin + VAL + g * GC, D, MH, GC, GC, nullptr, 0, nullptr, 0, pool_scale + g * GC);
        gemm<1>(stream, mixin, D, w_out, D, hh, D, MH, D, D, xh, D);
    }
    const int MC = 8192;
    float* f = ws;
    float* G = f + (size_t)MC * D;
    float* act = G + (size_t)MC * FF;
    for (int c = 0; c < M / MC; ++c) {
        float* hc = h + (size_t)c * MC * D;
        rmsnorm(stream, hc, D, ln_ffn, f, D, MC, D, 1);
        gemm<0>(stream, f, D, w_ffn_gate, FF, G, FF, MC, FF, D);
        gemm<2>(stream, f, D, w_ffn_up, FF, act, FF, MC, FF, D, G, FF);
        gemm<1>(stream, act, FF, w_ffn_down, D, hc, D, MC, D, FF, hc, D);
    }
    float* e = ws;
    float* G2 = e + (size_t)MC * D;
    for (int c = 0; c < M / MC; ++c) {
        float* hc = h + (size_t)c * MC * D;
        rmsnorm(stream, hc, D, ln_ple, e, D, MC, D, 1);
        gemm<0>(stream, e, D, w_ple_gate, D, G2, D, MC, D, D);
        gemm<3>(stream, p + (size_t)c * MC * DPLE, DPLE, w_ple_proj, D, hc, D, MC, D, DPLE, G2, D, hc, D);
    }
    rmsnorm(stream, h, D, ln_final, h, D, M, D, 1);
}
```

```cpp
#include <hip/hip_runtime.h>
#include <cstdio>
#include <cstdint>
#define MK_N_LAUNCHES 1
namespace pg8 {
#define PG8_LAS __attribute__((address_space(3)))
typedef unsigned short bf16_t;
typedef short bf16x8 __attribute__((ext_vector_type(8)));
typedef float f32x4 __attribute__((ext_vector_type(4)));
typedef unsigned u32x4 __attribute__((ext_vector_type(4)));
constexpr int BM = 256, BK = 64, HALF = 128, HTB = HALF * BK * 2  , STAGE_BYTES = 8 * HTB, NXCD = 8, WGM = 8;

__host__ __device__ __forceinline__ int lds_byte(int r, int c) { const int st = (r >> 4) * 2 + (c >> 5), rr = r & 15, cc = c & 31, ob = rr * 64 + cc * 2; return st * 1024 + (ob ^ (((ob >> 9) & 1) << 5)); }
__host__ __device__ __forceinline__ void stage_rc(int b, int& R, int& C) { const int st = b / 1024, sb = b % 1024, swz = sb ^ (((sb >> 9) & 1) << 5); R = (st >> 1) * 16 + swz / 64; C = (st & 1) * 32 + (swz % 64) / 2; }
__host__ __device__ __forceinline__ int perm32(int rho) { const int n = rho >> 4, i = rho & 15; return 8 * (i >> 2) + 4 * n + (i & 3); }

struct Unit { int pm, pn; };
struct Gemm { const bf16_t* A; const bf16_t* Bt; int M, N, K; };

struct StaticOrder {
    int nM, nN, nwg, G, c;
    __host__ __device__ void init(int M, int N, int G_, int c_) { nM = M / BM; nN = N / BM; nwg = nM * nN; G = G_; c = c_; }
    __host__ __device__ bool next(int i, Unit& u) const {
        const long L = (long)i * G + c; if (L >= nwg) return false;
        int wgid = (int)L; { const int q = nwg / NXCD, r = nwg % NXCD, xcd = wgid % NXCD, off = wgid / NXCD; wgid = (xcd < r ? xcd * (q + 1) : r * (q + 1) + (xcd - r) * q) + off; }
        const int nig = WGM * nN, gid = wgid / nig, fm = gid * WGM, gsz = (nM - fm) < WGM ? (nM - fm) : WGM;
        u.pm = fm + ((wgid % nig) % gsz); u.pn = (wgid % nig) / gsz; return true;
    }
    __device__ __forceinline__ void a_ready(const Unit&) const {}
    __device__ __forceinline__ void done(const Unit&) const {}
};

__device__ __forceinline__ unsigned cvt_pk_bf16(float lo, float hi) { unsigned r; asm volatile("v_cvt_pk_bf16_f32 %0, %1, %2" : "=v"(r) : "v"(lo), "v"(hi)); return r; }
typedef float f32x2 __attribute__((ext_vector_type(2)));
constexpr float RMS_EPS = 1e-6f;
__device__ __forceinline__ float sigmoid_f(float x) { return __builtin_amdgcn_rcpf(1.0f + __builtin_amdgcn_exp2f(-1.44269504f * x)); }
__device__ __forceinline__ float bf_lo(unsigned w) { return __uint_as_float(w << 16); }
__device__ __forceinline__ float bf_hi(unsigned w) { return __uint_as_float(w & 0xffff0000u); }
__device__ __forceinline__ float rstd16(const float* ssq, int row) {
    const f32x4* p = (const f32x4*)(ssq + (size_t)row * 16);
    const f32x4 a = p[0], b = p[1], c = p[2], d = p[3];
    const float s = ((a[0] + a[1]) + (a[2] + a[3])) + ((b[0] + b[1]) + (b[2] + b[3])) + ((c[0] + c[1]) + (c[2] + c[3])) + ((d[0] + d[1]) + (d[2] + d[3]));
    return __builtin_amdgcn_rsqf(s * (1.0f / 1024.0f) + RMS_EPS);
}
__device__ __forceinline__ u32x4 pack8(const f32x4 v0, const f32x4 v1) { u32x4 w; w.x = cvt_pk_bf16(v0[0], v0[1]); w.y = cvt_pk_bf16(v0[2], v0[3]); w.z = cvt_pk_bf16(v1[0], v1[1]); w.w = cvt_pk_bf16(v1[2], v1[3]); return w; }

struct EpiScaleBf16 {
    static constexpr bool PERM = true, AFTER_DRAIN = false;
    bf16_t* O; int ldc; const float* rs;
    __device__ __forceinline__ void operator()(const f32x4 (&acc)[2][2][4][2], const Unit& u, int wr, int wc, int fr, int fq) const {
        const int row0 = u.pm * BM + wr * 64 + fr, col0 = u.pn * BM + wc * 32 + 8 * fq;
#pragma unroll
        for (int ai = 0; ai < 2; ++ai)
#pragma unroll
            for (int m = 0; m < 4; ++m) { const int row = row0 + ai * HALF + m * 16; const float s = rs[row]; bf16_t* rowp = O + (size_t)row * ldc + col0;
#pragma unroll
                for (int bj = 0; bj < 2; ++bj) *(u32x4*)(rowp + bj * HALF) = pack8(acc[ai][bj][m][0] * s, acc[ai][bj][m][1] * s); }
    }
};
struct EpiPlainBf16 {
    static constexpr bool PERM = true, AFTER_DRAIN = false;
    bf16_t* O; int ldc;
    __device__ __forceinline__ void operator()(const f32x4 (&acc)[2][2][4][2], const Unit& u, int wr, int wc, int fr, int fq) const {
        const int row0 = u.pm * BM + wr * 64 + fr, col0 = u.pn * BM + wc * 32 + 8 * fq;
#pragma unroll
        for (int ai = 0; ai < 2; ++ai)
#pragma unroll
            for (int m = 0; m < 4; ++m) { bf16_t* rowp = O + (size_t)(row0 + ai * HALF + m * 16) * ldc + col0;
#pragma unroll
                for (int bj = 0; bj < 2; ++bj) *(u32x4*)(rowp + bj * HALF) = pack8(acc[ai][bj][m][0], acc[ai][bj][m][1]); }
    }
};
struct EpiResid {
    static constexpr bool PERM = true, AFTER_DRAIN = false;
    const float* base; float* out; bf16_t* ob; float* ssq;
    __device__ __forceinline__ void operator()(const f32x4 (&acc)[2][2][4][2], const Unit& u, int wr, int wc, int fr, int fq) const {
        const int row0 = u.pm * BM + wr * 64 + fr, col0 = u.pn * BM + wc * 32 + 8 * fq;
#pragma unroll
        for (int ai = 0; ai < 2; ++ai)
#pragma unroll
            for (int m = 0; m < 4; ++m) { const int row = row0 + ai * HALF + m * 16; float q = 0.f;
#pragma unroll
                for (int bj = 0; bj < 2; ++bj) { const size_t off = (size_t)row * 1024 + col0 + bj * HALF;
                    const f32x4 v0 = acc[ai][bj][m][0] + *(const f32x4*)(base + off), v1 = acc[ai][bj][m][1] + *(const f32x4*)(base + off + 4);
                    *(f32x4*)(out + off) = v0; *(f32x4*)(out + off + 4) = v1; *(u32x4*)(ob + off) = pack8(v0, v1);
                    q += ((v0[0] * v0[0] + v0[1] * v0[1]) + (v0[2] * v0[2] + v0[3] * v0[3])) + ((v1[0] * v1[0] + v1[1] * v1[1]) + (v1[2] * v1[2] + v1[3] * v1[3])); }
                q += __shfl_xor(q, 16); q += __shfl_xor(q, 32);
                if (fq == 0) ssq[(size_t)row * 16 + u.pn * 4 + wc] = q; }
    }
};
struct EpiSwiglu {
    static constexpr bool PERM = true, AFTER_DRAIN = false;
    bf16_t* O; int ldo; const float* ssq;
    __device__ __forceinline__ void operator()(const f32x4 (&acc)[2][2][4][2], const Unit& u, int wr, int wc, int fr, int fq) const {
        const int row0 = u.pm * BM + wr * 64 + fr, col0 = u.pn * HALF + wc * 32 + 8 * fq;
#pragma unroll
        for (int ai = 0; ai < 2; ++ai)
#pragma unroll
            for (int m = 0; m < 4; ++m) { const int row = row0 + ai * HALF + m * 16; const float rs = rstd16(ssq, row);
                f32x4 r[2];
#pragma unroll
                for (int n = 0; n < 2; ++n) { const f32x4 g = acc[ai][0][m][n] * rs, up = acc[ai][1][m][n] * rs;
#pragma unroll
                    for (int e = 0; e < 4; ++e) r[n][e] = g[e] * sigmoid_f(g[e]) * up[e]; }
                *(u32x4*)(O + (size_t)row * ldo + col0) = pack8(r[0], r[1]); }
    }
};
struct EpiPle {
    static constexpr bool PERM = true, AFTER_DRAIN = false;
    float* out; const bf16_t* pp; const float* ssq_in; float* ssq_out;
    __device__ __forceinline__ void operator()(const f32x4 (&acc)[2][2][4][2], const Unit& u, int wr, int wc, int fr, int fq) const {
        const int row0 = u.pm * BM + wr * 64 + fr, col0 = u.pn * BM + wc * 32 + 8 * fq;
#pragma unroll
        for (int ai = 0; ai < 2; ++ai)
#pragma unroll
            for (int m = 0; m < 4; ++m) { const int row = row0 + ai * HALF + m * 16; const float rs = rstd16(ssq_in, row); float q = 0.f;
#pragma unroll
                for (int bj = 0; bj < 2; ++bj) { const size_t off = (size_t)row * 1024 + col0 + bj * HALF;
                    const u32x4 pw = *(const u32x4*)(pp + off);
                    const f32x4 p0 = {bf_lo(pw.x), bf_hi(pw.x), bf_lo(pw.y), bf_hi(pw.y)}, p1 = {bf_lo(pw.z), bf_hi(pw.z), bf_lo(pw.w), bf_hi(pw.w)};
                    f32x4 v0 = *(const f32x4*)(out + off), v1 = *(const f32x4*)(out + off + 4);
                    const f32x4 g0 = acc[ai][bj][m][0] * rs, g1 = acc[ai][bj][m][1] * rs;
#pragma unroll
                    for (int e = 0; e < 4; ++e) { v0[e] += sigmoid_f(g0[e]) * p0[e]; v1[e] += sigmoid_f(g1[e]) * p1[e]; }
                    *(f32x4*)(out + off) = v0; *(f32x4*)(out + off + 4) = v1;
                    q += ((v0[0] * v0[0] + v0[1] * v0[1]) + (v0[2] * v0[2] + v0[3] * v0[3])) + ((v1[0] * v1[0] + v1[1] * v1[1]) + (v1[2] * v1[2] + v1[3] * v1[3])); }
                q += __shfl_xor(q, 16); q += __shfl_xor(q, 32);
                if (fq == 0) ssq_out[(size_t)row * 16 + u.pn * 4 + wc] = q;
                asm volatile("" ::: "memory"); }
    }
};

template <class Epi, class Sched, bool ALIGN_EPI = false, bool SP2 = false>
__device__ __forceinline__ void gemm_phase(PG8_LAS unsigned char* lds, const Gemm g, const Sched& S, const Epi& E) {
    int tid_ = threadIdx.x; asm volatile("" : "+v"(tid_));
    const int tid = tid_, wid = __builtin_amdgcn_readfirstlane(tid >> 6), lane = tid & 63, wr = wid >> 2, wc = wid & 3, fr = lane & 15, fq = lane >> 4;
    const int K = g.K, nt = K / BK;
    unsigned voffA[2], voffB[2];
#pragma unroll
    for (int i = 0; i < 2; ++i) { int R, C; stage_rc(tid * 16 + i * 8192, R, C); const int Rb = Epi::PERM ? ((R & ~31) + perm32(R & 31)) : R;
        voffA[i] = (unsigned)(R * K + C) * 2u; voffB[i] = (unsigned)(Rb * K + C) * 2u; }
    const size_t kstep = (size_t)(BK * 2);
    const size_t hstep = (size_t)HALF * K * 2;
    const size_t tstep = 2 * hstep;
    const unsigned ldsw = (unsigned)wid * 1024u;
    const int aoff = lds_byte(wr * 64 + fr, fq * 8), boff = lds_byte(wc * 32 + fr, fq * 8);
#define PG8_SA(b, h) (((b) * 2 + (h)) * HTB)
#define PG8_SB(b, h) ((4 + (b) * 2 + (h)) * HTB)
#define PG8_STAGE(bufoff, gbase, voff) do { _Pragma("unroll") for (int _i = 0; _i < 2; ++_i) \
        __builtin_amdgcn_global_load_lds((const unsigned*)((const char*)(gbase) + (voff)[_i]), (PG8_LAS unsigned*)(lds + (bufoff) + ldsw + _i * 8192), 16, 0, 0); } while (0)
#define PG8_LDA(dst, b, h) do { _Pragma("unroll") for (int m = 0; m < 4; ++m) _Pragma("unroll") for (int k = 0; k < 2; ++k) dst[m][k] = *(const PG8_LAS bf16x8*)(lds + PG8_SA(b, h) + aoff + m * 2048 + k * 1024); } while (0)
#define PG8_LDB(dst, b, h) do { _Pragma("unroll") for (int n = 0; n < 2; ++n) _Pragma("unroll") for (int k = 0; k < 2; ++k) dst[n][k] = *(const PG8_LAS bf16x8*)(lds + PG8_SB(b, h) + boff + n * 2048 + k * 1024); } while (0)
#define PG8_MMA(ai, bj, At, Bt) do { __builtin_amdgcn_s_setprio(1); _Pragma("unroll") for (int m = 0; m < 4; ++m) _Pragma("unroll") for (int n = 0; n < 2; ++n) _Pragma("unroll") for (int k = 0; k < 2; ++k) \
        acc[ai][bj][m][n] = __builtin_amdgcn_mfma_f32_16x16x32_bf16(Bt[n][k], At[m][k], acc[ai][bj][m][n], 0, 0, 0); __builtin_amdgcn_s_setprio(0); } while (0)
#define PG8_WAIT_V(n) asm volatile("s_waitcnt vmcnt(" #n ")" ::: "memory")
#define PG8_WAIT_L(n) asm volatile("s_waitcnt lgkmcnt(" #n ")" ::: "memory")
#define PG8_BAR __builtin_amdgcn_s_barrier()
#define PG8_SCHED __builtin_amdgcn_sched_barrier(0)
    Unit cur, nxt; int ui = 0;
    if (!S.next(0, cur)) return;
    f32x4 acc[2][2][4][2];
#pragma unroll
    for (int a = 0; a < 2; ++a)
#pragma unroll
        for (int b = 0; b < 2; ++b)
#pragma unroll
            for (int m = 0; m < 4; ++m)
#pragma unroll
                for (int n = 0; n < 2; ++n) acc[a][b][m][n] = (f32x4){0.f, 0.f, 0.f, 0.f};
    bf16x8 At[4][2], B0[2][2], B1[2][2];
    const char* cA = (const char*)g.A + (size_t)cur.pm * tstep; const char* cB = (const char*)g.Bt + (size_t)cur.pn * tstep;
    S.a_ready(cur);
    if constexpr (SP2) {
        PG8_STAGE(PG8_SB(0, 0), cB, voffB); PG8_STAGE(PG8_SB(0, 1), cB + hstep, voffB); PG8_STAGE(PG8_SA(0, 0), cA, voffA); PG8_STAGE(PG8_SA(0, 1), cA + hstep, voffA);
        if (wr == 1) PG8_BAR;
        PG8_WAIT_V(2); PG8_BAR;
        PG8_STAGE(PG8_SB(1, 0), cB + kstep, voffB); PG8_STAGE(PG8_SA(1, 0), cA + kstep, voffA); PG8_STAGE(PG8_SB(1, 1), cB + hstep + kstep, voffB);
        PG8_WAIT_V(6); PG8_BAR;
    } else {
        PG8_STAGE(PG8_SB(0, 0), cB, voffB); PG8_STAGE(PG8_SA(0, 0), cA, voffA); PG8_STAGE(PG8_SB(0, 1), cB + hstep, voffB); PG8_STAGE(PG8_SA(0, 1), cA + hstep, voffA);
        if (wr == 1) PG8_BAR;
        PG8_WAIT_V(4); PG8_BAR;
        PG8_STAGE(PG8_SB(1, 0), cB + kstep, voffB); PG8_STAGE(PG8_SA(1, 0), cA + kstep, voffA); PG8_STAGE(PG8_SB(1, 1), cB + hstep + kstep, voffB);
        PG8_WAIT_V(6); PG8_BAR;
    }
    for (;;) {
        const bool has_next = S.next(ui + 1, nxt);
        const char* nA = has_next ? (const char*)g.A + (size_t)nxt.pm * tstep : cA; const char* nB = has_next ? (const char*)g.Bt + (size_t)nxt.pn * tstep : cB;
        for (int t = 0; t < nt; t += 2) {
            const bool last = (t == nt - 2);
            const char* a1 = cA + (size_t)(t + 1) * kstep;
            const char* a2 = last ? nA : cA + (size_t)(t + 2) * kstep; const char* b2 = last ? nB : cB + (size_t)(t + 2) * kstep;
            const char* a3 = a2 + kstep; const char* b3 = b2 + kstep;
            if (last && has_next) S.a_ready(nxt);
            if constexpr (SP2) {
            PG8_LDB(B0, 0, 0); PG8_LDB(B1, 0, 1); PG8_SCHED; PG8_LDA(At, 0, 0); PG8_STAGE(PG8_SA(1, 1), a1 + hstep, voffA);
            PG8_WAIT_V(8); PG8_WAIT_L(0); PG8_BAR; PG8_MMA(0, 0, At, B0); PG8_MMA(0, 1, At, B1); PG8_BAR; PG8_SCHED;
            PG8_LDA(At, 0, 1); PG8_STAGE(PG8_SB(0, 0), b2, voffB); PG8_STAGE(PG8_SB(0, 1), b2 + hstep, voffB); PG8_STAGE(PG8_SA(0, 0), a2, voffA);
            PG8_WAIT_V(8); PG8_WAIT_L(0); PG8_BAR; PG8_MMA(1, 0, At, B0); PG8_MMA(1, 1, At, B1); PG8_BAR; PG8_SCHED;
            PG8_LDB(B0, 1, 0); PG8_LDB(B1, 1, 1); PG8_SCHED; PG8_LDA(At, 1, 0); PG8_STAGE(PG8_SA(0, 1), a2 + hstep, voffA);
            PG8_WAIT_V(8); PG8_WAIT_L(0); PG8_BAR; PG8_MMA(0, 0, At, B0); PG8_MMA(0, 1, At, B1); PG8_BAR; PG8_SCHED;
            PG8_LDA(At, 1, 1); PG8_STAGE(PG8_SB(1, 0), b3, voffB); PG8_STAGE(PG8_SB(1, 1), b3 + hstep, voffB); PG8_STAGE(PG8_SA(1, 0), a3, voffA);
            PG8_WAIT_V(8); PG8_WAIT_L(0); PG8_BAR; PG8_MMA(1, 0, At, B0); PG8_MMA(1, 1, At, B1); PG8_BAR; PG8_SCHED;
            } else {
            PG8_LDB(B0, 0, 0); PG8_SCHED; PG8_LDA(At, 0, 0); PG8_STAGE(PG8_SA(1, 1), a1 + hstep, voffA);
            PG8_WAIT_L(8); PG8_BAR; PG8_WAIT_L(0); PG8_MMA(0, 0, At, B0); PG8_BAR; PG8_SCHED;
            PG8_LDB(B1, 0, 1); PG8_STAGE(PG8_SB(0, 0), b2, voffB);
            PG8_BAR; PG8_WAIT_L(0); PG8_MMA(0, 1, At, B1); PG8_BAR;
            PG8_LDA(At, 0, 1); PG8_STAGE(PG8_SA(0, 0), a2, voffA);
            PG8_BAR; PG8_WAIT_L(0); PG8_MMA(1, 0, At, B0); PG8_BAR; PG8_SCHED;
            PG8_STAGE(PG8_SB(0, 1), b2 + hstep, voffB);
            PG8_WAIT_V(6); PG8_BAR; PG8_MMA(1, 1, At, B1); PG8_BAR;
            PG8_LDB(B0, 1, 0); PG8_SCHED; PG8_LDA(At, 1, 0); PG8_STAGE(PG8_SA(0, 1), a2 + hstep, voffA);
            PG8_WAIT_L(8); PG8_BAR; PG8_WAIT_L(0); PG8_MMA(0, 0, At, B0); PG8_BAR; PG8_SCHED;
            PG8_LDB(B1, 1, 1); PG8_STAGE(PG8_SB(1, 0), b3, voffB);
            PG8_BAR; PG8_WAIT_L(0); PG8_MMA(0, 1, At, B1); PG8_BAR;
            PG8_LDA(At, 1, 1); PG8_STAGE(PG8_SA(1, 0), a3, voffA);
            PG8_BAR; PG8_WAIT_L(0); PG8_MMA(1, 0, At, B0); PG8_BAR; PG8_SCHED;
            PG8_STAGE(PG8_SB(1, 1), b3 + hstep, voffB);
            PG8_WAIT_V(6); PG8_BAR; PG8_MMA(1, 1, At, B1); PG8_BAR;
            }
        }
        if constexpr (ALIGN_EPI) { if (wr == 0) PG8_BAR; }
        if constexpr (!Epi::AFTER_DRAIN) { int t2_ = threadIdx.x; asm volatile("" : "+v"(t2_)); const int l2_ = t2_ & 63;
            E(acc, cur, wr, wc, l2_ & 15, l2_ >> 4); S.done(cur); }
        if (!has_next) break;
#pragma unroll
        for (int a = 0; a < 2; ++a)
#pragma unroll
            for (int b = 0; b < 2; ++b)
#pragma unroll
                for (int m = 0; m < 4; ++m)
#pragma unroll
                    for (int n = 0; n < 2; ++n) acc[a][b][m][n] = (f32x4){0.f, 0.f, 0.f, 0.f};
        cur = nxt; cA = nA; cB = nB; ++ui;
        if constexpr (ALIGN_EPI) { if (wr == 1) PG8_BAR; }
    }
    PG8_WAIT_V(0);
    if constexpr (!ALIGN_EPI) { if (wr == 0) PG8_BAR; }
    PG8_BAR;
    if constexpr (Epi::AFTER_DRAIN) { E.fused(acc, cur, wr, wc, fr, fq, lds, wid, lane); S.done(cur); }
#undef PG8_SA
#undef PG8_SB
#undef PG8_STAGE
#undef PG8_LDA
#undef PG8_LDB
#undef PG8_MMA
#undef PG8_WAIT_V
#undef PG8_WAIT_L
#undef PG8_BAR
#undef PG8_SCHED
}
}
#ifndef PG8_SP2
#define PG8_SP2 true
#endif
#ifndef PG8_ALIGN
#define PG8_ALIGN true
#endif
constexpr int NWAVES = 8;
#ifndef MK_N_LAUNCHES
#define MK_N_LAUNCHES 1
#endif
constexpr int N_PHASES = 8;
constexpr int N_LAUNCHES = MK_N_LAUNCHES;

constexpr int BATCH = 16, T = 2048, D = 1024, M = BATCH * T;
constexpr int DPLE = 256, NH = 4, DK = 64, DV = 128, KEY = 256, VAL = 512, RANK = 16, POOLW = 512, GC = 128;
constexpr int DIN = 2064, FF = 2816, NZ = 2048, NGU = 2 * FF;
constexpr int ZQ = 0, ZK = 256, ZV = 512, ZG = 1024, ZU = 1536;
constexpr float EPS = 1e-6f;

constexpr size_t MiB = 1u << 20;
constexpr size_t WS_CTL = 0, CTL_ZERO_BYTES = 1 * MiB;
constexpr size_t WS_WIN = 1 * MiB, WS_WOUT = 5 * MiB, WS_WGU = 7 * MiB, WS_WD = 18 * MiB, WS_WPG = 24 * MiB, WS_WPP = 26 * MiB;
constexpr int TFIX = 4;
constexpr size_t WS_ZF = 27 * MiB + 256 * 1024;
constexpr size_t WS_RSX = 27 * MiB, WS_GLR = 28 * MiB, WS_SSQ1 = 30 * MiB, WS_SSQ2 = 32 * MiB, WS_SSQ3 = 34 * MiB;
constexpr size_t WS_XB = 36 * MiB, WS_Z = 100 * MiB, WS_ACT = 36 * MiB  , WS_A2 = 228 * MiB, WS_H2B = 228 * MiB  ;
constexpr size_t WS_H1B = 292 * MiB, WS_PP = 292 * MiB  , WS_PB = 356 * MiB, WS_END = 372 * MiB;
static_assert(WS_ACT + (size_t)M * FF * 2 <= WS_A2 && WS_Z + (size_t)M * NZ * 2 <= WS_A2 && WS_XB + (size_t)M * D * 2 <= WS_Z, "ws map");
static_assert(WS_WGU + (size_t)NGU * D * 2 <= WS_WD && WS_WD + (size_t)D * FF * 2 <= WS_WPG, "ws map (weights)");
constexpr int CW_TMO = 0, CW_CODE = 1;
constexpr int CW_BAR = 4096;

constexpr int RING_OFF = 0, RING_BYTES = 131072;
constexpr int LDSCTL_OFF = RING_BYTES, MISC_OFF = LDSCTL_OFF + 320;
constexpr int LDS_BYTES = 147456;
static_assert(MISC_OFF + 128 <= LDS_BYTES, "LDS map");

#define GAS __attribute__((address_space(1)))
#define LAS __attribute__((address_space(3)))
typedef unsigned short bf16;
typedef unsigned v4u __attribute__((ext_vector_type(4)));
typedef float f32x4 __attribute__((ext_vector_type(4)));
typedef short bf16x8 __attribute__((ext_vector_type(8)));
typedef GAS unsigned gu32;
typedef GAS unsigned long long gu64;
#define RLX_AGENT __ATOMIC_RELAXED, __HIP_MEMORY_SCOPE_AGENT
#define LDS_WAIT() asm volatile("s_waitcnt lgkmcnt(0)" ::: "memory")
#define VM_WAIT() asm volatile("s_waitcnt vmcnt(0)" ::: "memory")
__device__ __forceinline__ unsigned long long rt() { return __builtin_amdgcn_s_memrealtime(); }
__device__ __forceinline__ unsigned f2bf(float f) { unsigned u = __builtin_bit_cast(unsigned, f); return (u + 0x7fffu + ((u >> 16) & 1u)) >> 16; }
__device__ __forceinline__ unsigned pk2(float lo, float hi) { return f2bf(lo) | (f2bf(hi) << 16); }

#define XB_TMO      128
#define XB_XCNT(j)  (256  + 64 * (j))
#define XB_XSUB(j)  (1280 + 64 * (j))
#define XB_XGEN(j)  (2304 + 64 * (j))
#define XB_TOP      3328
#define XB_TOPGEN   3392
#define XCD_BAR_WORDS 3456
#define XB_SPIN_CAP (1u << 18)

__device__ __forceinline__ unsigned xb_ld(unsigned* p)              { return __hip_atomic_load(p, __ATOMIC_RELAXED, __HIP_MEMORY_SCOPE_AGENT); }
__device__ __forceinline__ unsigned xb_add(unsigned* p, unsigned v) { return __hip_atomic_fetch_add(p, v, __ATOMIC_RELAXED, __HIP_MEMORY_SCOPE_AGENT); }
__device__ __forceinline__ unsigned xb_xcc_id() { return (unsigned)__builtin_amdgcn_s_getreg((3 << 11) | 20) & 0xFu; }
#define XB_SPIN(cond, bar) do { unsigned _sp = 0; while (cond) { __builtin_amdgcn_s_sleep(1); \
    if ((++_sp & 255u) == 0u) { if (xb_ld(&(bar)[XB_TMO])) break; if (_sp > XB_SPIN_CAP) { atomicAdd(&(bar)[XB_TMO], 1u); break; } } } } while (0)

struct XcdBarrier {
    unsigned* bar; unsigned x;
    volatile LAS unsigned* st;
};

__device__ __forceinline__ XcdBarrier xcd_barrier_post(unsigned* bar, volatile LAS unsigned* st) {
    XcdBarrier b; b.bar = bar; b.x = xb_xcc_id(); b.st = st;
    if (threadIdx.x == 0) (void)xb_add(&bar[XB_XCNT(b.x)], 1u);
    return b;
}
__device__ __forceinline__ void xcd_barrier_complete(unsigned* bar, unsigned x, unsigned& nloc, unsigned& nx) {
    const unsigned G = gridDim.x * gridDim.y * gridDim.z;
    unsigned sum, cnt, mine, sp = 0u;
    for (;;) {
        sum = 0u; cnt = 0u; mine = 0u;
#pragma unroll
        for (unsigned j = 0; j < 16; ++j) { const unsigned c = xb_ld(&bar[XB_XCNT(j)]); sum += c; cnt += (c > 0u) ? 1u : 0u; mine = (j == x) ? c : mine; }
        if (sum == G) break;
        __builtin_amdgcn_s_sleep(1);
        if ((++sp & 255u) == 0u) { if (xb_ld(&bar[XB_TMO])) break; if (sp > XB_SPIN_CAP) { atomicAdd(&bar[XB_TMO], 1u); break; } }
    }
    nloc = mine > 0u ? mine : 1u; nx = cnt > 0u ? cnt : 1u;
}

__device__ __forceinline__ void xcd_barrier(const XcdBarrier& b) {
    asm volatile("s_waitcnt vmcnt(0)" ::: "memory");
    __syncthreads();
    if (threadIdx.x == 0) {
        unsigned* bar = b.bar;
        __builtin_amdgcn_s_waitcnt(0);
        unsigned nloc = b.st[0], nx = b.st[1];
        if (nloc == 0u) { xcd_barrier_complete(bar, b.x, nloc, nx); b.st[0] = nloc; b.st[1] = nx; }
        const unsigned old = xb_add(&bar[XB_XSUB(b.x)], 1u);
        const unsigned gen = old / nloc;
        if (old + 1u == (gen + 1u) * nloc) {
            __builtin_amdgcn_fence(__ATOMIC_RELEASE, "agent");
            asm volatile("s_waitcnt vmcnt(0)" ::: "memory");
            const unsigned og = xb_add(&bar[XB_TOP], 1u);
            const unsigned tg = og / nx;
            if (og + 1u == (tg + 1u) * nx) xb_add(&bar[XB_TOPGEN], 1u);
            else XB_SPIN(xb_ld(&bar[XB_TOPGEN]) == tg, bar);
            __builtin_amdgcn_fence(__ATOMIC_ACQUIRE, "agent");
            xb_add(&bar[XB_XGEN(b.x)], 1u);
            asm volatile("s_waitcnt vmcnt(0)" ::: "memory");
        } else {
            XB_SPIN(xb_ld(&bar[XB_XGEN(b.x)]) == gen, bar);
            __builtin_amdgcn_fence(__ATOMIC_ACQUIRE, "agent");
            asm volatile("s_waitcnt vmcnt(0)" ::: "memory");
        }
    }
    __syncthreads();
}

struct Frame {
    LAS unsigned char* lds;
    volatile LAS unsigned* MISC;
    gu32* ctl;
    int wave;
    int vcu, G;
    const float *x, *p, *ln_mix, *w_in, *w_gate_lr, *b_gate, *gla_norm, *w_pool, *pool_scale, *w_out, *ln_ffn, *w_gate, *w_up, *w_down, *ln_ple, *w_pg, *w_pp, *ln_final;
    float* out;
    bf16 *Win_t, *Wout_t, *Wgu_t, *Wd_t, *Wpg_t, *Wpp_t;
    float *rsx, *glr, *ssq1, *ssq2, *ssq3, *zf;
    bf16 *XB, *Z, *ACT, *A2, *H2B, *H1B, *PP, *PB;
};
__device__ __forceinline__ int my_tid() { int t = threadIdx.x; asm volatile("" : "+v"(t)); return t; }
__device__ __forceinline__ float wave_sum(float v) {
#pragma unroll
    for (int o = 1; o < 64; o <<= 1) v += __shfl_xor(v, o);
    return v;
}
__device__ __forceinline__ float bf2f(bf16 v) { return __uint_as_float((unsigned)v << 16); }

struct SrcPlain { const float* w; int N; __device__ __forceinline__ float operator()(int k, int n) const { return w[(size_t)k * N + n]; } };
struct SrcGain { const float* w; int N; const float* g; int cshift; __device__ __forceinline__ float operator()(int k, int n) const { return w[(size_t)k * N + n + cshift] * g[k]; } };
template <class S>
__device__ __forceinline__ void p0_transpose_item(const S& src, int K, bf16* WT, int k0, int n0, LAS float* scr, int lane) {
#pragma unroll 8
    for (int i = 0; i < 32; ++i) { const int kk = 2 * i + (lane >> 5); scr[kk * 33 + (lane & 31)] = src(k0 + kk, n0 + (lane & 31)); }
    LDS_WAIT(); asm volatile("" ::: "memory");
    const int c = lane & 7;
#pragma unroll
    for (int j = 0; j < 4; ++j) { const int n = (lane >> 3) + 8 * j; const LAS float* s = scr + (8 * c) * 33 + n;
        v4u o; o.x = pk2(s[0 * 33], s[1 * 33]); o.y = pk2(s[2 * 33], s[3 * 33]); o.z = pk2(s[4 * 33], s[5 * 33]); o.w = pk2(s[6 * 33], s[7 * 33]);
        *(GAS v4u*)(WT + (size_t)(n0 + n) * K + k0 + 8 * c) = o; }
    LDS_WAIT(); asm volatile("" ::: "memory");
}
__device__ __forceinline__ void p0_wcomb_item(Frame& F, int item) {
    const int nb = item & 15, cb = (item >> 4) & 7, g = item >> 7;
    const int n = nb * 64 + (my_tid() & 63), c0 = cb * 16;
    float acc[16];
#pragma unroll
    for (int j = 0; j < 16; ++j) acc[j] = 0.f;
    const float* wp = F.w_pool + (size_t)(g * GC + c0) * GC;
    for (int d = 0; d < GC; ++d) {
        const float wod = F.w_out[(size_t)(VAL + g * GC + d) * D + n] * F.pool_scale[g * GC + d];
#pragma unroll
        for (int j = 0; j < 16; ++j) acc[j] = fmaf(wp[j * GC + d], wod, acc[j]);
    }
    v4u o0, o1;
    o0.x = pk2(acc[0], acc[1]); o0.y = pk2(acc[2], acc[3]); o0.z = pk2(acc[4], acc[5]); o0.w = pk2(acc[6], acc[7]);
    o1.x = pk2(acc[8], acc[9]); o1.y = pk2(acc[10], acc[11]); o1.z = pk2(acc[12], acc[13]); o1.w = pk2(acc[14], acc[15]);
    GAS v4u* dst = (GAS v4u*)(F.Wout_t + (size_t)n * D + VAL + g * GC + c0);
    dst[0] = o0; dst[1] = o1;
}
__device__ __forceinline__ void p0_zf_item(Frame& F, int item) {
    const int b = item / 33, cc = item % 33, c = cc * 64 + (my_tid() & 63); const bool ok = c < DIN; const int cl = ok ? c : DIN - 1;
    const float* x0 = F.x + (size_t)b * T * D;
    float acc[TFIX], ss[TFIX];
#pragma unroll
    for (int t = 0; t < TFIX; ++t) { acc[t] = 0.f; ss[t] = 0.f; }
#pragma unroll 4
    for (int k = 0; k < D; ++k) {
        const float w = F.w_in[(size_t)k * DIN + cl] * F.ln_mix[k];
#pragma unroll
        for (int t = 0; t < TFIX; ++t) { const float xv = x0[t * D + k]; acc[t] = fmaf(xv, w, acc[t]); ss[t] = fmaf(xv, xv, ss[t]); }
    }
#pragma unroll
    for (int t = 0; t < TFIX; ++t) { const float rstd = 1.0f / sqrtf(ss[t] * (1.0f / D) + EPS); if (ok) F.zf[(size_t)(b * TFIX + t) * DIN + c] = acc[t] * rstd; }
}
constexpr int GLR_PITCH = 1032;
constexpr int P0_SCR_BYTES = 8704, P0_BT_OFF = NWAVES * P0_SCR_BYTES;
static_assert(P0_BT_OFF + RANK * GLR_PITCH * 2 <= RING_BYTES, "P0 LDS map");
__device__ __forceinline__ void p0_x_task(Frame& F, int task) {
    const int lane = my_tid() & 63; const int m0 = task * 16, row = lane & 15, kq = lane >> 4;
    const float* xr = F.x + (size_t)(m0 + row) * D + 8 * kq;
    bf16* xbr = F.XB + (size_t)(m0 + row) * D + 8 * kq;
    const LAS unsigned char* bt = F.lds + P0_BT_OFF + (row * GLR_PITCH + 8 * kq) * 2;
    pg8::f32x4 acc = {0.f, 0.f, 0.f, 0.f}; float ssq = 0.f;
#pragma unroll 4
    for (int kc = 0; kc < 32; ++kc) {
        const f32x4 a0 = *(const f32x4*)(xr + 32 * kc), a1 = *(const f32x4*)(xr + 32 * kc + 4);
        ssq += ((a0[0] * a0[0] + a0[1] * a0[1]) + (a0[2] * a0[2] + a0[3] * a0[3])) + ((a1[0] * a1[0] + a1[1] * a1[1]) + (a1[2] * a1[2] + a1[3] * a1[3]));
        v4u w; w.x = pk2(a0[0], a0[1]); w.y = pk2(a0[2], a0[3]); w.z = pk2(a1[0], a1[1]); w.w = pk2(a1[2], a1[3]);
        *(GAS v4u*)(xbr + 32 * kc) = w;
        const bf16x8 af = __builtin_bit_cast(bf16x8, w);
        const bf16x8 bfv = *(const LAS bf16x8*)(bt + 64 * kc);
        acc = __builtin_amdgcn_mfma_f32_16x16x32_bf16(af, bfv, acc, 0, 0, 0);
    }
    ssq += __shfl_xor(ssq, 16); ssq += __shfl_xor(ssq, 32);
    const float rstd = 1.0f / sqrtf(ssq * (1.0f / D) + EPS);
    if (lane < 16) F.rsx[m0 + lane] = rstd;
#pragma unroll
    for (int r = 0; r < 4; ++r) { const float rt = __shfl(rstd, 4 * kq + r); F.glr[(size_t)(m0 + 4 * kq + r) * RANK + row] = acc[r] * rt; }
}
__device__ __forceinline__ void p0_prologue(Frame& F) {
    const int tid = my_tid(), lane = tid & 63;
    for (int idx = tid; idx < RANK * D; idx += NWAVES * 64) { const int k = idx >> 4, r = idx & 15;
        *(LAS bf16*)(F.lds + P0_BT_OFF + (r * GLR_PITCH + k) * 2) = (bf16)f2bf(F.w_in[(size_t)k * DIN + 1536 + r] * F.ln_mix[k]); }
    __syncthreads();
    LAS float* scr = (LAS float*)(F.lds + RING_OFF + F.wave * P0_SCR_BYTES);
    const int gw = F.vcu * NWAVES + F.wave, NGW = F.G * NWAVES;
    if ((gw & 3) == 0) for (int it = gw >> 2; it < 512; it += (NGW >> 2)) p0_wcomb_item(F, it);
    if ((gw & 3) == 2) for (int it = gw >> 2; it < BATCH * 33; it += (NGW >> 2)) p0_zf_item(F, it);
    constexpr int I_IN = (D / 64) * (NZ / 32), I_OUT = (VAL / 64) * (D / 32), I_GU = (D / 64) * (NGU / 32), I_D = (FF / 64) * (D / 32), I_PG = (D / 64) * (D / 32), I_PP = (DPLE / 64) * (D / 32);
    constexpr int NITEMS = I_IN + I_OUT + I_GU + I_D + I_PG + I_PP;
    for (int it = gw; it < NITEMS; it += NGW) {
        int r = it;
        if (r < I_IN) { const int nblk = NZ / 32; const int n0 = 32 * (r % nblk); p0_transpose_item(SrcGain{F.w_in, DIN, F.ln_mix, n0 < 1536 ? 0 : 16}, D, F.Win_t, 64 * (r / nblk), n0, scr, lane); continue; } r -= I_IN;
        if (r < I_OUT) { const int nblk = D / 32; p0_transpose_item(SrcPlain{F.w_out, D}, D, F.Wout_t, 64 * (r / nblk), 32 * (r % nblk), scr, lane); continue; } r -= I_OUT;
        if (r < I_GU) { const int nblk = NGU / 32; const int n0 = 32 * (r % nblk), j = n0 >> 8, rr = n0 & 255;
            if (rr < 128) p0_transpose_item(SrcGain{F.w_gate, FF, F.ln_ffn, -128 * j}, D, F.Wgu_t, 64 * (r / nblk), n0, scr, lane);
            else p0_transpose_item(SrcGain{F.w_up, FF, F.ln_ffn, -128 * j - 128}, D, F.Wgu_t, 64 * (r / nblk), n0, scr, lane);
            continue; } r -= I_GU;
        if (r < I_D) { const int nblk = D / 32; p0_transpose_item(SrcPlain{F.w_down, D}, FF, F.Wd_t, 64 * (r / nblk), 32 * (r % nblk), scr, lane); continue; } r -= I_D;
        if (r < I_PG) { const int nblk = D / 32; p0_transpose_item(SrcGain{F.w_pg, D, F.ln_ple, 0}, D, F.Wpg_t, 64 * (r / nblk), 32 * (r % nblk), scr, lane); continue; } r -= I_PG;
        { const int nblk = D / 32; p0_transpose_item(SrcPlain{F.w_pp, D}, DPLE, F.Wpp_t, 64 * (r / nblk), 32 * (r % nblk), scr, lane); }
    }
    for (int t = gw; t < M / 16; t += NGW) p0_x_task(F, t);
    for (size_t i = (size_t)(F.vcu * NWAVES * 64 + tid); i < (size_t)M * DPLE / 8; i += (size_t)F.G * NWAVES * 64) {
        const f32x4 a0 = *(const f32x4*)(F.p + 8 * i), a1 = *(const f32x4*)(F.p + 8 * i + 4);
        v4u w; w.x = pk2(a0[0], a0[1]); w.y = pk2(a0[2], a0[3]); w.z = pk2(a1[0], a1[1]); w.w = pk2(a1[2], a1[3]);
        *(GAS v4u*)(F.PB + 8 * i) = w;
    }
}

__device__ __forceinline__ void p2_gla_simple(Frame& F, int bh) {
    const int b = bh >> 2, h = bh & 3, tid = my_tid(), lane = tid & 63;
    LAS float* sq = (LAS float*)(F.lds); LAS float* sk = sq + 64; LAS float* sa = sk + 64; LAS float* red = sa + 64;
    float S[DK]; float wgc[RANK]; float bg = 0.f, gn = 0.f;
#pragma unroll
    for (int d = 0; d < DK; ++d) S[d] = 0.f;
#pragma unroll
    for (int r = 0; r < RANK; ++r) wgc[r] = (tid < 64) ? F.w_gate_lr[r * KEY + h * DK + tid] : 0.f;
    if (tid < 64) bg = F.b_gate[h * DK + tid];
    if (tid < 128) gn = F.gla_norm[tid];
    for (int t = 0; t < T; ++t) {
        const size_t m = (size_t)b * T + t;
        if (tid < 64) {
            float pre = bg;
#pragma unroll
            for (int r = 0; r < RANK; ++r) pre = fmaf(F.glr[m * RANK + r], wgc[r], pre);
            const float ls = fminf(pre, 0.f) - log1pf(expf(-fabsf(pre)));
            sa[tid] = expf(ls * (1.0f / 16.0f));
            sq[tid] = bf2f(F.Z[m * NZ + ZQ + h * DK + tid]) * 0.125f;
            sk[tid] = bf2f(F.Z[m * NZ + ZK + h * DK + tid]);
        }
        __syncthreads();
        float o = 0.f;
        if (tid < 128) {
            const float vv = bf2f(F.Z[m * NZ + ZV + h * DV + tid]);
#pragma unroll
            for (int d = 0; d < DK; ++d) { S[d] = fmaf(sa[d], S[d], sk[d] * vv); o = fmaf(sq[d], S[d], o); }
            const float s2 = wave_sum(o * o);
            if (lane == 0) red[F.wave] = s2;
        }
        __syncthreads();
        if (tid < 128) {
            const float rstd = 1.0f / sqrtf((red[0] + red[1]) * (1.0f / DV) + EPS);
            const float g = bf2f(F.Z[m * NZ + ZG + h * DV + tid]);
            const float val = o * rstd * gn * (g / (1.0f + expf(-g)));
            F.A2[m * D + h * DV + tid] = (bf16)f2bf(val);
        }
    }
}
__device__ __forceinline__ void p2_gla_fix(Frame& F, int bh) {
    const int b = bh >> 2, h = bh & 3, tid = my_tid(), lane = tid & 63;
    LAS float* sq = (LAS float*)(F.lds); LAS float* sk = sq + 64; LAS float* sa = sk + 64; LAS float* red = sa + 64;
    float S[DK]; float wgc[RANK]; float bg = 0.f, gn = 0.f;
#pragma unroll
    for (int d = 0; d < DK; ++d) S[d] = 0.f;
#pragma unroll
    for (int r = 0; r < RANK; ++r) wgc[r] = (tid < 64) ? F.w_gate_lr[r * KEY + h * DK + tid] : 0.f;
    if (tid < 64) bg = F.b_gate[h * DK + tid];
    if (tid < 128) gn = F.gla_norm[tid];
    __syncthreads();
    for (int t = 0; t < TFIX; ++t) {
        const float* zr = F.zf + (size_t)(b * TFIX + t) * DIN; const size_t m = (size_t)b * T + t;
        if (tid < 64) {
            float pre = bg;
#pragma unroll
            for (int r = 0; r < RANK; ++r) pre = fmaf(zr[1536 + r], wgc[r], pre);
            const float ls = fminf(pre, 0.f) - log1pf(expf(-fabsf(pre)));
            sa[tid] = expf(ls * (1.0f / 16.0f));
            sq[tid] = zr[h * DK + tid] * 0.125f;
            sk[tid] = zr[256 + h * DK + tid];
        }
        __syncthreads();
        float o = 0.f;
        if (tid < 128) {
            const float vv = zr[512 + h * DV + tid];
#pragma unroll
            for (int d = 0; d < DK; ++d) { S[d] = fmaf(sa[d], S[d], sk[d] * vv); o = fmaf(sq[d], S[d], o); }
            const float s2 = wave_sum(o * o);
            if (lane == 0) red[F.wave] = s2;
        }
        __syncthreads();
        if (tid < 128) {
            const float rstd = 1.0f / sqrtf((red[0] + red[1]) * (1.0f / DV) + EPS);
            const float g = zr[1024 + h * DV + tid];
            const float val = o * rstd * gn * (g / (1.0f + expf(-g)));
            F.A2[m * D + h * DV + tid] = (bf16)f2bf(val);
        }
    }
}
__device__ __forceinline__ void p2_pool_simple(Frame& F, int start, int stride) {
    for (int i = start; i < M * (POOLW / 8); i += stride) {
        const int m = i >> 6, c8 = i & 63, c = c8 * 8, t = m & (T - 1), g = c >> 7;
        const int w = 2 << g, cnt = (t + 1 < w) ? (t + 1) : w;
        float s[8];
#pragma unroll
        for (int e = 0; e < 8; ++e) s[e] = 0.f;
        float u0[8];
        for (int j = 0; j < cnt; ++j) {
            const v4u pw = *(const GAS v4u*)(F.Z + (size_t)(m - j) * NZ + ZU + c);
            const float v[8] = {pg8::bf_lo(pw.x), pg8::bf_hi(pw.x), pg8::bf_lo(pw.y), pg8::bf_hi(pw.y), pg8::bf_lo(pw.z), pg8::bf_hi(pw.z), pg8::bf_lo(pw.w), pg8::bf_hi(pw.w)};
#pragma unroll
            for (int e = 0; e < 8; ++e) { s[e] += v[e]; if (j == 0) u0[e] = v[e]; }
        }
        const float inv = 1.0f / (float)cnt;
        v4u o; o.x = pk2(s[0] * inv - u0[0], s[1] * inv - u0[1]); o.y = pk2(s[2] * inv - u0[2], s[3] * inv - u0[3]);
        o.z = pk2(s[4] * inv - u0[4], s[5] * inv - u0[5]); o.w = pk2(s[6] * inv - u0[6], s[7] * inv - u0[7]);
        *(GAS v4u*)(F.A2 + (size_t)m * D + VAL + c) = o;
    }
}
__device__ __forceinline__ void p7_final(Frame& F) {
    const int gw = F.vcu * NWAVES + F.wave, NGW = F.G * NWAVES, lane = my_tid() & 63;
    f32x4 gv[4];
#pragma unroll
    for (int j = 0; j < 4; ++j) gv[j] = *(const f32x4*)(F.ln_final + 4 * lane + 256 * j);
    for (int m = gw; m < M; m += NGW) {
        float s = (lane < 16) ? F.ssq3[(size_t)m * 16 + lane] : 0.f;
        s = wave_sum(s);
        const float rstd = 1.0f / sqrtf(s * (1.0f / D) + EPS);
        GAS f32x4* o = (GAS f32x4*)(F.out + (size_t)m * D) + lane;
#pragma unroll
        for (int j = 0; j < 4; ++j) { f32x4 v = o[64 * j]; v = v * rstd * gv[j]; o[64 * j] = v; }
    }
}

struct Args { const float* in[18]; float* out; unsigned char* ws; int ph_lo, ph_hi, li, pad; };
__global__ void __launch_bounds__(NWAVES * 64, 2) mk_fwd(Args args) {
    extern __shared__ __attribute__((aligned(16))) unsigned char lds[];
    Frame F;
    F.lds = (LAS unsigned char*)lds;
    F.MISC = (volatile LAS unsigned*)(F.lds + MISC_OFF);
    F.wave = __builtin_amdgcn_readfirstlane((int)threadIdx.x >> 6);
    F.G = gridDim.x; { const int bx = blockIdx.x; F.vcu = (F.G % 8 == 0) ? (bx % 8) * (F.G / 8) + bx / 8 : bx; }
    unsigned char* ws = args.ws;
    F.ctl = (gu32*)(ws + WS_CTL);
    F.x = args.in[0]; F.p = args.in[1]; F.ln_mix = args.in[2]; F.w_in = args.in[3]; F.w_gate_lr = args.in[4]; F.b_gate = args.in[5]; F.gla_norm = args.in[6];
    F.w_pool = args.in[7]; F.pool_scale = args.in[8]; F.w_out = args.in[9]; F.ln_ffn = args.in[10]; F.w_gate = args.in[11]; F.w_up = args.in[12]; F.w_down = args.in[13];
    F.ln_ple = args.in[14]; F.w_pg = args.in[15]; F.w_pp = args.in[16]; F.ln_final = args.in[17]; F.out = args.out;
    F.Win_t = (bf16*)(ws + WS_WIN); F.Wout_t = (bf16*)(ws + WS_WOUT); F.Wgu_t = (bf16*)(ws + WS_WGU); F.Wd_t = (bf16*)(ws + WS_WD); F.Wpg_t = (bf16*)(ws + WS_WPG); F.Wpp_t = (bf16*)(ws + WS_WPP);
    F.zf = (float*)(ws + WS_ZF); F.rsx = (float*)(ws + WS_RSX); F.glr = (float*)(ws + WS_GLR); F.ssq1 = (float*)(ws + WS_SSQ1); F.ssq2 = (float*)(ws + WS_SSQ2); F.ssq3 = (float*)(ws + WS_SSQ3);
    F.XB = (bf16*)(ws + WS_XB); F.Z = (bf16*)(ws + WS_Z); F.ACT = (bf16*)(ws + WS_ACT); F.A2 = (bf16*)(ws + WS_A2); F.H2B = (bf16*)(ws + WS_H2B);
    F.H1B = (bf16*)(ws + WS_H1B); F.PP = (bf16*)(ws + WS_PP); F.PB = (bf16*)(ws + WS_PB);
    for (int u = threadIdx.x; u < (LDS_BYTES - LDSCTL_OFF) / 4; u += NWAVES * 64) ((LAS unsigned*)(F.lds + LDSCTL_OFF))[u] = 0u;
    __syncthreads();
    XcdBarrier bar; bar.bar = (unsigned*)(F.ctl + CW_BAR); bar.x = 0; bar.st = nullptr;
    if (N_LAUNCHES == 1) bar = xcd_barrier_post((unsigned*)(F.ctl + CW_BAR), F.MISC + 8);
#define GRID_BAR(seam) do { if (N_LAUNCHES != 1) { if (threadIdx.x == 0) __hip_atomic_store(F.ctl + CW_TMO, 0xBADBA0u | (unsigned)(seam), RLX_AGENT); } else { xcd_barrier(bar); } } while (0)
    const int lo = args.ph_lo, hi = args.ph_hi;
#ifndef PHASE_MASK
#define PHASE_MASK 0xff
#endif
#define IN(k) (((PHASE_MASK >> (k)) & 1) && lo <= (k) && (k) < hi)
#define BOTH(k) (IN(k) && IN((k) + 1))

    if (IN(0)) { p0_prologue(F); if (BOTH(0)) GRID_BAR(0); }

    if (IN(1)) {
        pg8::Gemm g{F.XB, F.Win_t, M, NZ, D}; pg8::StaticOrder S; S.init(M, NZ, F.G, (int)blockIdx.x);
        pg8::EpiScaleBf16 E{F.Z, NZ, F.rsx};
        pg8::gemm_phase<pg8::EpiScaleBf16, pg8::StaticOrder, PG8_ALIGN, PG8_SP2>(F.lds + RING_OFF, g, S, E);
        if (BOTH(1)) GRID_BAR(1);
    }

    if (IN(2)) {
        if ((int)blockIdx.x < 64 || F.G < 128) { for (int bh = blockIdx.x; bh < BATCH * NH; bh += F.G) { p2_gla_simple(F, bh); p2_gla_fix(F, bh); } }
        if (F.G < 128) p2_pool_simple(F, (int)blockIdx.x * NWAVES * 64 + my_tid(), F.G * NWAVES * 64);
        else if ((int)blockIdx.x >= 64) p2_pool_simple(F, ((int)blockIdx.x - 64) * NWAVES * 64 + my_tid(), (F.G - 64) * NWAVES * 64);
        if (BOTH(2)) GRID_BAR(2);
    }

    if (IN(3)) {
        pg8::Gemm g{F.A2, F.Wout_t, M, D, D}; pg8::StaticOrder S; S.init(M, D, F.G, (int)blockIdx.x);
        pg8::EpiResid E{F.x, F.out, F.H1B, F.ssq1};
        pg8::gemm_phase<pg8::EpiResid, pg8::StaticOrder, PG8_ALIGN, PG8_SP2>(F.lds + RING_OFF, g, S, E);
        if (BOTH(3)) GRID_BAR(3);
    }

    if (IN(4)) {
        pg8::Gemm g{F.H1B, F.Wgu_t, M, NGU, D}; pg8::StaticOrder S; S.init(M, NGU, F.G, (int)blockIdx.x);
        pg8::EpiSwiglu E{F.ACT, FF, F.ssq1};
        pg8::gemm_phase<pg8::EpiSwiglu, pg8::StaticOrder, PG8_ALIGN, PG8_SP2>(F.lds + RING_OFF, g, S, E);
        if (BOTH(4)) GRID_BAR(4);
    }

    if (IN(5)) {
        pg8::Gemm g{F.ACT, F.Wd_t, M, D, FF}; pg8::StaticOrder S; S.init(M, D, F.G, (int)blockIdx.x);
        pg8::EpiResid E{F.out, F.out, F.H2B, F.ssq2};
        pg8::gemm_phase<pg8::EpiResid, pg8::StaticOrder, PG8_ALIGN, PG8_SP2>(F.lds + RING_OFF, g, S, E);
        if (BOTH(5)) GRID_BAR(5);
    }

    if (IN(6)) {
#ifndef SKIP_PP
        { pg8::Gemm g{F.PB, F.Wpp_t, M, D, DPLE}; pg8::StaticOrder S; S.init(M, D, F.G, (int)blockIdx.x);
          pg8::EpiPlainBf16 E{F.PP, D};
          pg8::gemm_phase<pg8::EpiPlainBf16, pg8::StaticOrder, PG8_ALIGN, PG8_SP2>(F.lds + RING_OFF, g, S, E); }
#endif
#ifndef SKIP_PLE
        { pg8::Gemm g{F.H2B, F.Wpg_t, M, D, D}; pg8::StaticOrder S; S.init(M, D, F.G, (int)blockIdx.x);
          pg8::EpiPle E{F.out, F.PP, F.ssq2, F.ssq3};
          pg8::gemm_phase<pg8::EpiPle, pg8::StaticOrder, PG8_ALIGN, PG8_SP2>(F.lds + RING_OFF, g, S, E); }
#endif
        if (BOTH(6)) GRID_BAR(6);
    }

    if (IN(7)) { p7_final(F); }
#undef IN
#undef BOTH
}

extern "C" void kernel_launch(void* const* d_in, const int* in_sizes, int n_in, void* d_out, int out_size, void* d_ws, size_t ws_size, hipStream_t stream) {
    static int grid = 0;
    if (grid == 0) {
        if (n_in != 18 || in_sizes[0] != M * D || out_size != M * D || ws_size < WS_END) { fprintf(stderr, "kernel_launch: unexpected shapes (n_in %d, in0 %d, out %d, ws %zu); nothing launched\n", n_in, n_in > 0 ? in_sizes[0] : -1, out_size, ws_size); grid = -1; return; }
        int dev = 0, cus = 0, per_cu = 0;
        if (hipGetDevice(&dev) != hipSuccess || hipDeviceGetAttribute(&cus, hipDeviceAttributeMultiprocessorCount, dev) != hipSuccess) { fprintf(stderr, "kernel_launch: device query failed\n"); grid = -1; return; }
        if (hipFuncSetAttribute((const void*)mk_fwd, hipFuncAttributeMaxDynamicSharedMemorySize, LDS_BYTES) != hipSuccess) { fprintf(stderr, "kernel_launch: hipFuncSetAttribute failed\n"); grid = -1; return; }
        if (hipOccupancyMaxActiveBlocksPerMultiprocessor(&per_cu, (const void*)mk_fwd, NWAVES * 64, LDS_BYTES) != hipSuccess || per_cu < 1)
            fprintf(stderr, "kernel_launch: note: occupancy query reports %d workgroups per CU\n", per_cu);
        (void)hipGetLastError();
        grid = cus;
    }
    if (grid < 0) return;
    if (hipMemsetAsync((char*)d_ws + WS_CTL, 0, CTL_ZERO_BYTES, stream) != hipSuccess) { fprintf(stderr, "kernel_launch: hipMemsetAsync failed\n"); return; }
    Args a{};
    for (int i = 0; i < 18; ++i) a.in[i] = (const float*)d_in[i];
    a.out = (float*)d_out; a.ws = (unsigned char*)d_ws;
    for (int li = 0; li < N_LAUNCHES; ++li) {
        a.ph_lo = (N_LAUNCHES == 1) ? 0 : li; a.ph_hi = (N_LAUNCHES == 1) ? N_PHASES : li + 1; a.li = li;
        hipLaunchKernelGGL(mk_fwd, dim3(grid), dim3(NWAVES * 64), LDS_BYTES, stream, a);
        const hipError_t le = hipPeekAtLastError();
        if (le != hipSuccess) { fprintf(stderr, "kernel_launch: launch %d failed: %s\n", li, hipGetErrorName(le)); break; }
    }
}
```

```cpp
#include <hip/hip_runtime.h>
#include <cstdio>
#include <cstdint>
#define MK_N_LAUNCHES 1
namespace pg8 {
#define PG8_LAS __attribute__((address_space(3)))
typedef unsigned short bf16_t;
typedef short bf16x8 __attribute__((ext_vector_type(8)));
typedef float f32x4 __attribute__((ext_vector_type(4)));
typedef unsigned u32x4 __attribute__((ext_vector_type(4)));
constexpr int BM = 256, BK = 64, HALF = 128, HTB = HALF * BK * 2  , STAGE_BYTES = 8 * HTB, NXCD = 8, WGM = 8;

__host__ __device__ __forceinline__ int lds_byte(int r, int c) { const int st = (r >> 4) * 2 + (c >> 5), rr = r & 15, cc = c & 31, ob = rr * 64 + cc * 2; return st * 1024 + (ob ^ (((ob >> 9) & 1) << 5)); }
__host__ __device__ __forceinline__ void stage_rc(int b, int& R, int& C) { const int st = b / 1024, sb = b % 1024, swz = sb ^ (((sb >> 9) & 1) << 5); R = (st >> 1) * 16 + swz / 64; C = (st & 1) * 32 + (swz % 64) / 2; }
__host__ __device__ __forceinline__ int perm32(int rho) { const int n = rho >> 4, i = rho & 15; return 8 * (i >> 2) + 4 * n + (i & 3); }

struct Unit { int pm, pn; };
struct Gemm { const bf16_t* A; const bf16_t* Bt; int M, N, K; };

struct StaticOrder {
    int nM, nN, nwg, G, c;
    __host__ __device__ void init(int M, int N, int G_, int c_) { nM = M / BM; nN = N / BM; nwg = nM * nN; G = G_; c = c_; }
    __host__ __device__ bool next(int i, Unit& u) const {
        const long L = (long)i * G + c; if (L >= nwg) return false;
        int wgid = (int)L; { const int q = nwg / NXCD, r = nwg % NXCD, xcd = wgid % NXCD, off = wgid / NXCD; wgid = (xcd < r ? xcd * (q + 1) : r * (q + 1) + (xcd - r) * q) + off; }
        const int nig = WGM * nN, gid = wgid / nig, fm = gid * WGM, gsz = (nM - fm) < WGM ? (nM - fm) : WGM;
        u.pm = fm + ((wgid % nig) % gsz); u.pn = (wgid % nig) / gsz; return true;
    }
    __device__ __forceinline__ void a_ready(const Unit&) const {}
    __device__ __forceinline__ void done(const Unit&) const {}
};

__device__ __forceinline__ unsigned cvt_pk_bf16(float lo, float hi) { unsigned r; asm volatile("v_cvt_pk_bf16_f32 %0, %1, %2" : "=v"(r) : "v"(lo), "v"(hi)); return r; }
typedef float f32x2 __attribute__((ext_vector_type(2)));
constexpr float RMS_EPS = 1e-6f;
__device__ __forceinline__ float sigmoid_f(float x) { return __builtin_amdgcn_rcpf(1.0f + __builtin_amdgcn_exp2f(-1.44269504f * x)); }
__device__ __forceinline__ float bf_lo(unsigned w) { return __uint_as_float(w << 16); }
__device__ __forceinline__ float bf_hi(unsigned w) { return __uint_as_float(w & 0xffff0000u); }
__device__ __forceinline__ float rstd16(const float* ssq, int row) {
    const f32x4* p = (const f32x4*)(ssq + (size_t)row * 16);
    const f32x4 a = p[0], b = p[1], c = p[2], d = p[3];
    const float s = ((a[0] + a[1]) + (a[2] + a[3])) + ((b[0] + b[1]) + (b[2] + b[3])) + ((c[0] + c[1]) + (c[2] + c[3])) + ((d[0] + d[1]) + (d[2] + d[3]));
    return __builtin_amdgcn_rsqf(s * (1.0f / 1024.0f) + RMS_EPS);
}
__device__ __forceinline__ u32x4 pack8(const f32x4 v0, const f32x4 v1) { u32x4 w; w.x = cvt_pk_bf16(v0[0], v0[1]); w.y = cvt_pk_bf16(v0[2], v0[3]); w.z = cvt_pk_bf16(v1[0], v1[1]); w.w = cvt_pk_bf16(v1[2], v1[3]); return w; }

struct EpiScaleBf16 {
    static constexpr bool PERM = true, AFTER_DRAIN = false;
    bf16_t* O; int ldc; const float* rs;
    __device__ __forceinline__ void operator()(const f32x4 (&acc)[2][2][4][2], const Unit& u, int wr, int wc, int fr, int fq) const {
        const int row0 = u.pm * BM + wr * 64 + fr, col0 = u.pn * BM + wc * 32 + 8 * fq;
#pragma unroll
        for (int ai = 0; ai < 2; ++ai)
#pragma unroll
            for (int m = 0; m < 4; ++m) { const int row = row0 + ai * HALF + m * 16; const float s = rs[row]; bf16_t* rowp = O + (size_t)row * ldc + col0;
#pragma unroll
                for (int bj = 0; bj < 2; ++bj) *(u32x4*)(rowp + bj * HALF) = pack8(acc[ai][bj][m][0] * s, acc[ai][bj][m][1] * s); }
    }
};
struct EpiPlainBf16 {
    static constexpr bool PERM = true, AFTER_DRAIN = false;
    bf16_t* O; int ldc;
    __device__ __forceinline__ void operator()(const f32x4 (&acc)[2][2][4][2], const Unit& u, int wr, int wc, int fr, int fq) const {
        const int row0 = u.pm * BM + wr * 64 + fr, col0 = u.pn * BM + wc * 32 + 8 * fq;
#pragma unroll
        for (int ai = 0; ai < 2; ++ai)
#pragma unroll
            for (int m = 0; m < 4; ++m) { bf16_t* rowp = O + (size_t)(row0 + ai * HALF + m * 16) * ldc + col0;
#pragma unroll
                for (int bj = 0; bj < 2; ++bj) *(u32x4*)(rowp + bj * HALF) = pack8(acc[ai][bj][m][0], acc[ai][bj][m][1]); }
    }
};
struct EpiResid {
    static constexpr bool PERM = true, AFTER_DRAIN = false;
    const float* base; float* out; bf16_t* ob; float* ssq;
    __device__ __forceinline__ void operator()(const f32x4 (&acc)[2][2][4][2], const Unit& u, int wr, int wc, int fr, int fq) const {
        const int row0 = u.pm * BM + wr * 64 + fr, col0 = u.pn * BM + wc * 32 + 8 * fq;
#pragma unroll
        for (int ai = 0; ai < 2; ++ai)
#pragma unroll
            for (int m = 0; m < 4; ++m) { const int row = row0 + ai * HALF + m * 16; float q = 0.f;
#pragma unroll
                for (int bj = 0; bj < 2; ++bj) { const size_t off = (size_t)row * 1024 + col0 + bj * HALF;
                    const f32x4 v0 = acc[ai][bj][m][0] + *(const f32x4*)(base + off), v1 = acc[ai][bj][m][1] + *(const f32x4*)(base + off + 4);
                    *(f32x4*)(out + off) = v0; *(f32x4*)(out + off + 4) = v1; *(u32x4*)(ob + off) = pack8(v0, v1);
                    q += ((v0[0] * v0[0] + v0[1] * v0[1]) + (v0[2] * v0[2] + v0[3] * v0[3])) + ((v1[0] * v1[0] + v1[1] * v1[1]) + (v1[2] * v1[2] + v1[3] * v1[3])); }
                q += __shfl_xor(q, 16); q += __shfl_xor(q, 32);
                if (fq == 0) ssq[(size_t)row * 16 + u.pn * 4 + wc] = q; }
    }
};
struct EpiSwiglu {
    static constexpr bool PERM = true, AFTER_DRAIN = false;
    bf16_t* O; int ldo; const float* ssq;
    __device__ __forceinline__ void operator()(const f32x4 (&acc)[2][2][4][2], const Unit& u, int wr, int wc, int fr, int fq) const {
        const int row0 = u.pm * BM + wr * 64 + fr, col0 = u.pn * HALF + wc * 32 + 8 * fq;
#pragma unroll
        for (int ai = 0; ai < 2; ++ai)
#pragma unroll
            for (int m = 0; m < 4; ++m) { const int row = row0 + ai * HALF + m * 16; const float rs = rstd16(ssq, row);
                f32x4 r[2];
#pragma unroll
                for (int n = 0; n < 2; ++n) { const f32x4 g = acc[ai][0][m][n] * rs, up = acc[ai][1][m][n] * rs;
#pragma unroll
                    for (int e = 0; e < 4; ++e) r[n][e] = g[e] * sigmoid_f(g[e]) * up[e]; }
                *(u32x4*)(O + (size_t)row * ldo + col0) = pack8(r[0], r[1]); }
    }
};
struct EpiPle {
    static constexpr bool PERM = true, AFTER_DRAIN = false;
    float* out; const bf16_t* pp; const float* ssq_in; float* ssq_out;
    __device__ __forceinline__ void operator()(const f32x4 (&acc)[2][2][4][2], const Unit& u, int wr, int wc, int fr, int fq) const {
        const int row0 = u.pm * BM + wr * 64 + fr, col0 = u.pn * BM + wc * 32 + 8 * fq;
#pragma unroll
        for (int ai = 0; ai < 2; ++ai)
#pragma unroll
            for (int m = 0; m < 4; ++m) { const int row = row0 + ai * HALF + m * 16; const float rs = rstd16(ssq_in, row); float q = 0.f;
#pragma unroll
                for (int bj = 0; bj < 2; ++bj) { const size_t off = (size_t)row * 1024 + col0 + bj * HALF;
                    const u32x4 pw = *(const u32x4*)(pp + off);
                    const f32x4 p0 = {bf_lo(pw.x), bf_hi(pw.x), bf_lo(pw.y), bf_hi(pw.y)}, p1 = {bf_lo(pw.z), bf_hi(pw.z), bf_lo(pw.w), bf_hi(pw.w)};
                    f32x4 v0 = *(const f32x4*)(out + off), v1 = *(const f32x4*)(out + off + 4);
                    const f32x4 g0 = acc[ai][bj][m][0] * rs, g1 = acc[ai][bj][m][1] * rs;
#pragma unroll
                    for (int e = 0; e < 4; ++e) { v0[e] += sigmoid_f(g0[e]) * p0[e]; v1[e] += sigmoid_f(g1[e]) * p1[e]; }
                    *(f32x4*)(out + off) = v0; *(f32x4*)(out + off + 4) = v1;
                    q += ((v0[0] * v0[0] + v0[1] * v0[1]) + (v0[2] * v0[2] + v0[3] * v0[3])) + ((v1[0] * v1[0] + v1[1] * v1[1]) + (v1[2] * v1[2] + v1[3] * v1[3])); }
                q += __shfl_xor(q, 16); q += __shfl_xor(q, 32);
                if (fq == 0) ssq_out[(size_t)row * 16 + u.pn * 4 + wc] = q;
                asm volatile("" ::: "memory"); }
    }
};

template <class Epi, class Sched, bool ALIGN_EPI = false, bool SP2 = false>
__device__ __forceinline__ void gemm_phase(PG8_LAS unsigned char* lds, const Gemm g, const Sched& S, const Epi& E) {
    int tid_ = threadIdx.x; asm volatile("" : "+v"(tid_));
    const int tid = tid_, wid = __builtin_amdgcn_readfirstlane(tid >> 6), lane = tid & 63, wr = wid >> 2, wc = wid & 3, fr = lane & 15, fq = lane >> 4;
    const int K = g.K, nt = K / BK;
    unsigned voffA[2], voffB[2];
#pragma unroll
    for (int i = 0; i < 2; ++i) { int R, C; stage_rc(tid * 16 + i * 8192, R, C); const int Rb = Epi::PERM ? ((R & ~31) + perm32(R & 31)) : R;
        voffA[i] = (unsigned)(R * K + C) * 2u; voffB[i] = (unsigned)(Rb * K + C) * 2u; }
    const size_t kstep = (size_t)(BK * 2);
    const size_t hstep = (size_t)HALF * K * 2;
    const size_t tstep = 2 * hstep;
    const unsigned ldsw = (unsigned)wid * 1024u;
    const int aoff = lds_byte(wr * 64 + fr, fq * 8), boff = lds_byte(wc * 32 + fr, fq * 8);
#define PG8_SA(b, h) (((b) * 2 + (h)) * HTB)
#define PG8_SB(b, h) ((4 + (b) * 2 + (h)) * HTB)
#define PG8_STAGE(bufoff, gbase, voff) do { _Pragma("unroll") for (int _i = 0; _i < 2; ++_i) \
        __builtin_amdgcn_global_load_lds((const unsigned*)((const char*)(gbase) + (voff)[_i]), (PG8_LAS unsigned*)(lds + (bufoff) + ldsw + _i * 8192), 16, 0, 0); } while (0)
#define PG8_LDA(dst, b, h) do { _Pragma("unroll") for (int m = 0; m < 4; ++m) _Pragma("unroll") for (int k = 0; k < 2; ++k) dst[m][k] = *(const PG8_LAS bf16x8*)(lds + PG8_SA(b, h) + aoff + m * 2048 + k * 1024); } while (0)
#define PG8_LDB(dst, b, h) do { _Pragma("unroll") for (int n = 0; n < 2; ++n) _Pragma("unroll") for (int k = 0; k < 2; ++k) dst[n][k] = *(const PG8_LAS bf16x8*)(lds + PG8_SB(b, h) + boff + n * 2048 + k * 1024); } while (0)
#define PG8_MMA(ai, bj, At, Bt) do { __builtin_amdgcn_s_setprio(1); _Pragma("unroll") for (int m = 0; m < 4; ++m) _Pragma("unroll") for (int n = 0; n < 2; ++n) _Pragma("unroll") for (int k = 0; k < 2; ++k) \
        acc[ai][bj][m][n] = __builtin_amdgcn_mfma_f32_16x16x32_bf16(Bt[n][k], At[m][k], acc[ai][bj][m][n], 0, 0, 0); __builtin_amdgcn_s_setprio(0); } while (0)
#define PG8_WAIT_V(n) asm volatile("s_waitcnt vmcnt(" #n ")" ::: "memory")
#define PG8_WAIT_L(n) asm volatile("s_waitcnt lgkmcnt(" #n ")" ::: "memory")
#define PG8_BAR __builtin_amdgcn_s_barrier()
#define PG8_SCHED __builtin_amdgcn_sched_barrier(0)
    Unit cur, nxt; int ui = 0;
    if (!S.next(0, cur)) return;
    f32x4 acc[2][2][4][2];
#pragma unroll
    for (int a = 0; a < 2; ++a)
#pragma unroll
        for (int b = 0; b < 2; ++b)
#pragma unroll
            for (int m = 0; m < 4; ++m)
#pragma unroll
                for (int n = 0; n < 2; ++n) acc[a][b][m][n] = (f32x4){0.f, 0.f, 0.f, 0.f};
    bf16x8 At[4][2], B0[2][2], B1[2][2];
    const char* cA = (const char*)g.A + (size_t)cur.pm * tstep; const char* cB = (const char*)g.Bt + (size_t)cur.pn * tstep;
    S.a_ready(cur);
    if constexpr (SP2) {
        PG8_STAGE(PG8_SB(0, 0), cB, voffB); PG8_STAGE(PG8_SB(0, 1), cB + hstep, voffB); PG8_STAGE(PG8_SA(0, 0), cA, voffA); PG8_STAGE(PG8_SA(0, 1), cA + hstep, voffA);
        if (wr == 1) PG8_BAR;
        PG8_WAIT_V(2); PG8_BAR;
        PG8_STAGE(PG8_SB(1, 0), cB + kstep, voffB); PG8_STAGE(PG8_SA(1, 0), cA + kstep, voffA); PG8_STAGE(PG8_SB(1, 1), cB + hstep + kstep, voffB);
        PG8_WAIT_V(6); PG8_BAR;
    } else {
        PG8_STAGE(PG8_SB(0, 0), cB, voffB); PG8_STAGE(PG8_SA(0, 0), cA, voffA); PG8_STAGE(PG8_SB(0, 1), cB + hstep, voffB); PG8_STAGE(PG8_SA(0, 1), cA + hstep, voffA);
        if (wr == 1) PG8_BAR;
        PG8_WAIT_V(4); PG8_BAR;
        PG8_STAGE(PG8_SB(1, 0), cB + kstep, voffB); PG8_STAGE(PG8_SA(1, 0), cA + kstep, voffA); PG8_STAGE(PG8_SB(1, 1), cB + hstep + kstep, voffB);
        PG8_WAIT_V(6); PG8_BAR;
    }
    for (;;) {
        const bool has_next = S.next(ui + 1, nxt);
        const char* nA = has_next ? (const char*)g.A + (size_t)nxt.pm * tstep : cA; const char* nB = has_next ? (const char*)g.Bt + (size_t)nxt.pn * tstep : cB;
        for (int t = 0; t < nt; t += 2) {
            const bool last = (t == nt - 2);
            const char* a1 = cA + (size_t)(t + 1) * kstep;
            const char* a2 = last ? nA : cA + (size_t)(t + 2) * kstep; const char* b2 = last ? nB : cB + (size_t)(t + 2) * kstep;
            const char* a3 = a2 + kstep; const char* b3 = b2 + kstep;
            if (last && has_next) S.a_ready(nxt);
            if constexpr (SP2) {
            PG8_LDB(B0, 0, 0); PG8_LDB(B1, 0, 1); PG8_SCHED; PG8_LDA(At, 0, 0); PG8_STAGE(PG8_SA(1, 1), a1 + hstep, voffA);
            PG8_WAIT_V(8); PG8_WAIT_L(0); PG8_BAR; PG8_MMA(0, 0, At, B0); PG8_MMA(0, 1, At, B1); PG8_BAR; PG8_SCHED;
            PG8_LDA(At, 0, 1); PG8_STAGE(PG8_SB(0, 0), b2, voffB); PG8_STAGE(PG8_SB(0, 1), b2 + hstep, voffB); PG8_STAGE(PG8_SA(0, 0), a2, voffA);
            PG8_WAIT_V(8); PG8_WAIT_L(0); PG8_BAR; PG8_MMA(1, 0, At, B0); PG8_MMA(1, 1, At, B1); PG8_BAR; PG8_SCHED;
            PG8_LDB(B0, 1, 0); PG8_LDB(B1, 1, 1); PG8_SCHED; PG8_LDA(At, 1, 0); PG8_STAGE(PG8_SA(0, 1), a2 + hstep, voffA);
            PG8_WAIT_V(8); PG8_WAIT_L(0); PG8_BAR; PG8_MMA(0, 0, At, B0); PG8_MMA(0, 1, At, B1); PG8_BAR; PG8_SCHED;
            PG8_LDA(At, 1, 1); PG8_STAGE(PG8_SB(1, 0), b3, voffB); PG8_STAGE(PG8_SB(1, 1), b3 + hstep, voffB); PG8_STAGE(PG8_SA(1, 0), a3, voffA);
            PG8_WAIT_V(8); PG8_WAIT_L(0); PG8_BAR; PG8_MMA(1, 0, At, B0); PG8_MMA(1, 1, At, B1); PG8_BAR; PG8_SCHED;
            } else {
            PG8_LDB(B0, 0, 0); PG8_SCHED; PG8_LDA(At, 0, 0); PG8_STAGE(PG8_SA(1, 1), a1 + hstep, voffA);
            PG8_WAIT_L(8); PG8_BAR; PG8_WAIT_L(0); PG8_MMA(0, 0, At, B0); PG8_BAR; PG8_SCHED;
            PG8_LDB(B1, 0, 1); PG8_STAGE(PG8_SB(0, 0), b2, voffB);
            PG8_BAR; PG8_WAIT_L(0); PG8_MMA(0, 1, At, B1); PG8_BAR;
            PG8_LDA(At, 0, 1); PG8_STAGE(PG8_SA(0, 0), a2, voffA);
            PG8_BAR; PG8_WAIT_L(0); PG8_MMA(1, 0, At, B0); PG8_BAR; PG8_SCHED;
            PG8_STAGE(PG8_SB(0, 1), b2 + hstep, voffB);
            PG8_WAIT_V(6); PG8_BAR; PG8_MMA(1, 1, At, B1); PG8_BAR;
            PG8_LDB(B0, 1, 0); PG8_SCHED; PG8_LDA(At, 1, 0); PG8_STAGE(PG8_SA(0, 1), a2 + hstep, voffA);
            PG8_WAIT_L(8); PG8_BAR; PG8_WAIT_L(0); PG8_MMA(0, 0, At, B0); PG8_BAR; PG8_SCHED;
            PG8_LDB(B1, 1, 1); PG8_STAGE(PG8_SB(1, 0), b3, voffB);
            PG8_BAR; PG8_WAIT_L(0); PG8_MMA(0, 1, At, B1); PG8_BAR;
            PG8_LDA(At, 1, 1); PG8_STAGE(PG8_SA(1, 0), a3, voffA);
            PG8_BAR; PG8_WAIT_L(0); PG8_MMA(1, 0, At, B0); PG8_BAR; PG8_SCHED;
            PG8_STAGE(PG8_SB(1, 1), b3 + hstep, voffB);
            PG8_WAIT_V(6); PG8_BAR; PG8_MMA(1, 1, At, B1); PG8_BAR;
            }
        }
        if constexpr (ALIGN_EPI) { if (wr == 0) PG8_BAR; }
        if constexpr (!Epi::AFTER_DRAIN) { int t2_ = threadIdx.x; asm volatile("" : "+v"(t2_)); const int l2_ = t2_ & 63;
            E(acc, cur, wr, wc, l2_ & 15, l2_ >> 4); S.done(cur); }
        if (!has_next) break;
#pragma unroll
        for (int a = 0; a < 2; ++a)
#pragma unroll
            for (int b = 0; b < 2; ++b)
#pragma unroll
                for (int m = 0; m < 4; ++m)
#pragma unroll
                    for (int n = 0; n < 2; ++n) acc[a][b][m][n] = (f32x4){0.f, 0.f, 0.f, 0.f};
        cur = nxt; cA = nA; cB = nB; ++ui;
        if constexpr (ALIGN_EPI) { if (wr == 1) PG8_BAR; }
    }
    PG8_WAIT_V(0);
    if constexpr (!ALIGN_EPI) { if (wr == 0) PG8_BAR; }
    PG8_BAR;
    if constexpr (Epi::AFTER_DRAIN) { E.fused(acc, cur, wr, wc, fr, fq, lds, wid, lane); S.done(cur); }
#undef PG8_SA
#undef PG8_SB
#undef PG8_STAGE
#undef PG8_LDA
#undef PG8_LDB
#undef PG8_MMA
#undef PG8_WAIT_V
#undef PG8_WAIT_L
#undef PG8_BAR
#undef PG8_SCHED
}
}
#ifndef PG8_SP2
#define PG8_SP2 true
#endif
#ifndef PG8_ALIGN
#define PG8_ALIGN true
#endif
constexpr int NWAVES = 8;
#ifndef MK_N_LAUNCHES
#define MK_N_LAUNCHES 1
#endif
constexpr int N_PHASES = 8;
constexpr int N_LAUNCHES = MK_N_LAUNCHES;

constexpr int BATCH = 16, T = 2048, D = 1024, M = BATCH * T;
constexpr int DPLE = 256, NH = 4, DK = 64, DV = 128, KEY = 256, VAL = 512, RANK = 16, POOLW = 512, GC = 128;
constexpr int DIN = 2064, FF = 2816, NZ = 2048, NGU = 2 * FF;
constexpr int ZQ = 0, ZK = 256, ZV = 512, ZG = 1024, ZU = 1536;
constexpr float EPS = 1e-6f;

constexpr size_t MiB = 1u << 20;
constexpr size_t WS_CTL = 0, CTL_ZERO_BYTES = 1 * MiB;
constexpr size_t WS_WIN = 1 * MiB, WS_WOUT = 5 * MiB, WS_WGU = 7 * MiB, WS_WD = 18 * MiB, WS_WPG = 24 * MiB, WS_WPP = 26 * MiB;
constexpr int TFIX = 4;
constexpr size_t WS_ZF = 27 * MiB + 256 * 1024;
constexpr size_t WS_RSX = 27 * MiB, WS_GLR = 28 * MiB, WS_SSQ1 = 30 * MiB, WS_SSQ2 = 32 * MiB, WS_SSQ3 = 34 * MiB;
constexpr size_t WS_XB = 36 * MiB, WS_Z = 100 * MiB, WS_ACT = 36 * MiB  , WS_A2 = 228 * MiB, WS_H2B = 228 * MiB  ;
constexpr size_t WS_H1B = 292 * MiB, WS_PP = 292 * MiB  , WS_PB = 356 * MiB, WS_GLRB = 372 * MiB  , WS_END = 373 * MiB;
static_assert(WS_ACT + (size_t)M * FF * 2 <= WS_A2 && WS_Z + (size_t)M * NZ * 2 <= WS_A2 && WS_XB + (size_t)M * D * 2 <= WS_Z, "ws map");
static_assert(WS_WGU + (size_t)NGU * D * 2 <= WS_WD && WS_WD + (size_t)D * FF * 2 <= WS_WPG, "ws map (weights)");
constexpr int CW_TMO = 0, CW_CODE = 1;
constexpr int CW_BAR = 4096;

constexpr int RING_OFF = 0, RING_BYTES = 131072;
constexpr int LDSCTL_OFF = RING_BYTES, MISC_OFF = LDSCTL_OFF + 320;
constexpr int LDS_BYTES = 147456;
static_assert(MISC_OFF + 128 <= LDS_BYTES, "LDS map");

#define GAS __attribute__((address_space(1)))
#define LAS __attribute__((address_space(3)))
typedef unsigned short bf16;
typedef unsigned v4u __attribute__((ext_vector_type(4)));
typedef float f32x4 __attribute__((ext_vector_type(4)));
typedef short bf16x8 __attribute__((ext_vector_type(8)));
typedef GAS unsigned gu32;
typedef GAS unsigned long long gu64;
#define RLX_AGENT __ATOMIC_RELAXED, __HIP_MEMORY_SCOPE_AGENT
#define LDS_WAIT() asm volatile("s_waitcnt lgkmcnt(0)" ::: "memory")
#define VM_WAIT() asm volatile("s_waitcnt vmcnt(0)" ::: "memory")
__device__ __forceinline__ unsigned long long rt() { return __builtin_amdgcn_s_memrealtime(); }
__device__ __forceinline__ unsigned f2bf(float f) { unsigned u = __builtin_bit_cast(unsigned, f); return (u + 0x7fffu + ((u >> 16) & 1u)) >> 16; }
__device__ __forceinline__ unsigned pk2(float lo, float hi) { return f2bf(lo) | (f2bf(hi) << 16); }

#define XB_TMO      128
#define XB_XCNT(j)  (256  + 64 * (j))
#define XB_XSUB(j)  (1280 + 64 * (j))
#define XB_XGEN(j)  (2304 + 64 * (j))
#define XB_TOP      3328
#define XB_TOPGEN   3392
#define XCD_BAR_WORDS 3456
#define XB_SPIN_CAP (1u << 18)

__device__ __forceinline__ unsigned xb_ld(unsigned* p)              { return __hip_atomic_load(p, __ATOMIC_RELAXED, __HIP_MEMORY_SCOPE_AGENT); }
__device__ __forceinline__ unsigned xb_add(unsigned* p, unsigned v) { return __hip_atomic_fetch_add(p, v, __ATOMIC_RELAXED, __HIP_MEMORY_SCOPE_AGENT); }
__device__ __forceinline__ unsigned xb_xcc_id() { return (unsigned)__builtin_amdgcn_s_getreg((3 << 11) | 20) & 0xFu; }
#define XB_SPIN(cond, bar) do { unsigned _sp = 0; while (cond) { __builtin_amdgcn_s_sleep(1); \
    if ((++_sp & 255u) == 0u) { if (xb_ld(&(bar)[XB_TMO])) break; if (_sp > XB_SPIN_CAP) { atomicAdd(&(bar)[XB_TMO], 1u); break; } } } } while (0)

struct XcdBarrier {
    unsigned* bar; unsigned x;
    volatile LAS unsigned* st;
};

__device__ __forceinline__ XcdBarrier xcd_barrier_post(unsigned* bar, volatile LAS unsigned* st) {
    XcdBarrier b; b.bar = bar; b.x = xb_xcc_id(); b.st = st;
    if (threadIdx.x == 0) (void)xb_add(&bar[XB_XCNT(b.x)], 1u);
    return b;
}
__device__ __forceinline__ void xcd_barrier_complete(unsigned* bar, unsigned x, unsigned& nloc, unsigned& nx) {
    const unsigned G = gridDim.x * gridDim.y * gridDim.z;
    unsigned sum, cnt, mine, sp = 0u;
    for (;;) {
        sum = 0u; cnt = 0u; mine = 0u;
#pragma unroll
        for (unsigned j = 0; j < 16; ++j) { const unsigned c = xb_ld(&bar[XB_XCNT(j)]); sum += c; cnt += (c > 0u) ? 1u : 0u; mine = (j == x) ? c : mine; }
        if (sum == G) break;
        __builtin_amdgcn_s_sleep(1);
        if ((++sp & 255u) == 0u) { if (xb_ld(&bar[XB_TMO])) break; if (sp > XB_SPIN_CAP) { atomicAdd(&bar[XB_TMO], 1u); break; } }
    }
    nloc = mine > 0u ? mine : 1u; nx = cnt > 0u ? cnt : 1u;
}

__device__ __forceinline__ void xcd_barrier(const XcdBarrier& b) {
    asm volatile("s_waitcnt vmcnt(0)" ::: "memory");
    __syncthreads();
    if (threadIdx.x == 0) {
        unsigned* bar = b.bar;
        __builtin_amdgcn_s_waitcnt(0);
        unsigned nloc = b.st[0], nx = b.st[1];
        if (nloc == 0u) { xcd_barrier_complete(bar, b.x, nloc, nx); b.st[0] = nloc; b.st[1] = nx; }
        const unsigned old = xb_add(&bar[XB_XSUB(b.x)], 1u);
        const unsigned gen = old / nloc;
        if (old + 1u == (gen + 1u) * nloc) {
            __builtin_amdgcn_fence(__ATOMIC_RELEASE, "agent");
            asm volatile("s_waitcnt vmcnt(0)" ::: "memory");
            const unsigned og = xb_add(&bar[XB_TOP], 1u);
            const unsigned tg = og / nx;
            if (og + 1u == (tg + 1u) * nx) xb_add(&bar[XB_TOPGEN], 1u);
            else XB_SPIN(xb_ld(&bar[XB_TOPGEN]) == tg, bar);
            __builtin_amdgcn_fence(__ATOMIC_ACQUIRE, "agent");
            xb_add(&bar[XB_XGEN(b.x)], 1u);
            asm volatile("s_waitcnt vmcnt(0)" ::: "memory");
        } else {
            XB_SPIN(xb_ld(&bar[XB_XGEN(b.x)]) == gen, bar);
            __builtin_amdgcn_fence(__ATOMIC_ACQUIRE, "agent");
            asm volatile("s_waitcnt vmcnt(0)" ::: "memory");
        }
    }
    __syncthreads();
}

struct Frame {
    LAS unsigned char* lds;
    volatile LAS unsigned* MISC;
    gu32* ctl;
    int wave;
    int vcu, G;
    const float *x, *p, *ln_mix, *w_in, *w_gate_lr, *b_gate, *gla_norm, *w_pool, *pool_scale, *w_out, *ln_ffn, *w_gate, *w_up, *w_down, *ln_ple, *w_pg, *w_pp, *ln_final;
    float* out;
    bf16 *Win_t, *Wout_t, *Wgu_t, *Wd_t, *Wpg_t, *Wpp_t;
    float *rsx, *glr, *ssq1, *ssq2, *ssq3, *zf;
    bf16* glrb;
    bf16 *XB, *Z, *ACT, *A2, *H2B, *H1B, *PP, *PB;
};
__device__ __forceinline__ int my_tid() { int t = threadIdx.x; asm volatile("" : "+v"(t)); return t; }
__device__ __forceinline__ float wave_sum(float v) {
#pragma unroll
    for (int o = 1; o < 64; o <<= 1) v += __shfl_xor(v, o);
    return v;
}
__device__ __forceinline__ float bf2f(bf16 v) { return __uint_as_float((unsigned)v << 16); }

struct SrcPlain { const float* w; int N; __device__ __forceinline__ float operator()(int k, int n) const { return w[(size_t)k * N + n]; } };
struct SrcGain { const float* w; int N; const float* g; int cshift; __device__ __forceinline__ float operator()(int k, int n) const { return w[(size_t)k * N + n + cshift] * g[k]; } };
template <class S>
__device__ __forceinline__ void p0_transpose_item(const S& src, int K, bf16* WT, int k0, int n0, LAS float* scr, int lane) {
#pragma unroll 8
    for (int i = 0; i < 32; ++i) { const int kk = 2 * i + (lane >> 5); scr[kk * 33 + (lane & 31)] = src(k0 + kk, n0 + (lane & 31)); }
    LDS_WAIT(); asm volatile("" ::: "memory");
    const int c = lane & 7;
#pragma unroll
    for (int j = 0; j < 4; ++j) { const int n = (lane >> 3) + 8 * j; const LAS float* s = scr + (8 * c) * 33 + n;
        v4u o; o.x = pk2(s[0 * 33], s[1 * 33]); o.y = pk2(s[2 * 33], s[3 * 33]); o.z = pk2(s[4 * 33], s[5 * 33]); o.w = pk2(s[6 * 33], s[7 * 33]);
        *(GAS v4u*)(WT + (size_t)(n0 + n) * K + k0 + 8 * c) = o; }
    LDS_WAIT(); asm volatile("" ::: "memory");
}
__device__ __forceinline__ void p0_wcomb_item(Frame& F, int item) {
    const int nb = item & 15, cb = (item >> 4) & 7, g = item >> 7;
    const int n = nb * 64 + (my_tid() & 63), c0 = cb * 16;
    float acc[16];
#pragma unroll
    for (int j = 0; j < 16; ++j) acc[j] = 0.f;
    const float* wp = F.w_pool + (size_t)(g * GC + c0) * GC;
    for (int d = 0; d < GC; ++d) {
        const float wod = F.w_out[(size_t)(VAL + g * GC + d) * D + n] * F.pool_scale[g * GC + d];
#pragma unroll
        for (int j = 0; j < 16; ++j) acc[j] = fmaf(wp[j * GC + d], wod, acc[j]);
    }
    v4u o0, o1;
    o0.x = pk2(acc[0], acc[1]); o0.y = pk2(acc[2], acc[3]); o0.z = pk2(acc[4], acc[5]); o0.w = pk2(acc[6], acc[7]);
    o1.x = pk2(acc[8], acc[9]); o1.y = pk2(acc[10], acc[11]); o1.z = pk2(acc[12], acc[13]); o1.w = pk2(acc[14], acc[15]);
    GAS v4u* dst = (GAS v4u*)(F.Wout_t + (size_t)n * D + VAL + g * GC + c0);
    dst[0] = o0; dst[1] = o1;
}
__device__ __forceinline__ void p0_zf_item(Frame& F, int item) {
    const int b = item / 33, cc = item % 33, c = cc * 64 + (my_tid() & 63); const bool ok = c < DIN; const int cl = ok ? c : DIN - 1;
    const float* x0 = F.x + (size_t)b * T * D;
    float acc[TFIX], ss[TFIX];
#pragma unroll
    for (int t = 0; t < TFIX; ++t) { acc[t] = 0.f; ss[t] = 0.f; }
#pragma unroll 4
    for (int k = 0; k < D; ++k) {
        const float w = F.w_in[(size_t)k * DIN + cl] * F.ln_mix[k];
#pragma unroll
        for (int t = 0; t < TFIX; ++t) { const float xv = x0[t * D + k]; acc[t] = fmaf(xv, w, acc[t]); ss[t] = fmaf(xv, xv, ss[t]); }
    }
#pragma unroll
    for (int t = 0; t < TFIX; ++t) { const float rstd = 1.0f / sqrtf(ss[t] * (1.0f / D) + EPS); if (ok) F.zf[(size_t)(b * TFIX + t) * DIN + c] = acc[t] * rstd; }
}
constexpr int GLR_PITCH = 1032;
constexpr int P0_SCR_BYTES = 8704, P0_BT_OFF = NWAVES * P0_SCR_BYTES;
static_assert(P0_BT_OFF + RANK * GLR_PITCH * 2 <= RING_BYTES, "P0 LDS map");
__device__ __forceinline__ void p0_x_task(Frame& F, int task) {
    const int lane = my_tid() & 63; const int m0 = task * 16, row = lane & 15, kq = lane >> 4;
    const float* xr = F.x + (size_t)(m0 + row) * D + 8 * kq;
    bf16* xbr = F.XB + (size_t)(m0 + row) * D + 8 * kq;
    const LAS unsigned char* bt = F.lds + P0_BT_OFF + (row * GLR_PITCH + 8 * kq) * 2;
    pg8::f32x4 acc = {0.f, 0.f, 0.f, 0.f}; float ssq = 0.f;
#pragma unroll 4
    for (int kc = 0; kc < 32; ++kc) {
        const f32x4 a0 = *(const f32x4*)(xr + 32 * kc), a1 = *(const f32x4*)(xr + 32 * kc + 4);
        ssq += ((a0[0] * a0[0] + a0[1] * a0[1]) + (a0[2] * a0[2] + a0[3] * a0[3])) + ((a1[0] * a1[0] + a1[1] * a1[1]) + (a1[2] * a1[2] + a1[3] * a1[3]));
        v4u w; w.x = pk2(a0[0], a0[1]); w.y = pk2(a0[2], a0[3]); w.z = pk2(a1[0], a1[1]); w.w = pk2(a1[2], a1[3]);
        *(GAS v4u*)(xbr + 32 * kc) = w;
        const bf16x8 af = __builtin_bit_cast(bf16x8, w);
        const bf16x8 bfv = *(const LAS bf16x8*)(bt + 64 * kc);
        acc = __builtin_amdgcn_mfma_f32_16x16x32_bf16(af, bfv, acc, 0, 0, 0);
    }
    ssq += __shfl_xor(ssq, 16); ssq += __shfl_xor(ssq, 32);
    const float rstd = 1.0f / sqrtf(ssq * (1.0f / D) + EPS);
    if (lane < 16) F.rsx[m0 + lane] = rstd;
#pragma unroll
    for (int r = 0; r < 4; ++r) { const float rt = __shfl(rstd, 4 * kq + r); const float gv = acc[r] * rt; F.glr[(size_t)(m0 + 4 * kq + r) * RANK + row] = gv; F.glrb[(size_t)(m0 + 4 * kq + r) * RANK + row] = (bf16)f2bf(gv); }
}
__device__ __forceinline__ void p0_prologue(Frame& F) {
    const int tid = my_tid(), lane = tid & 63;
    for (int idx = tid; idx < RANK * D; idx += NWAVES * 64) { const int k = idx >> 4, r = idx & 15;
        *(LAS bf16*)(F.lds + P0_BT_OFF + (r * GLR_PITCH + k) * 2) = (bf16)f2bf(F.w_in[(size_t)k * DIN + 1536 + r] * F.ln_mix[k]); }
    __syncthreads();
    LAS float* scr = (LAS float*)(F.lds + RING_OFF + F.wave * P0_SCR_BYTES);
    const int gw = F.vcu * NWAVES + F.wave, NGW = F.G * NWAVES;
    if ((gw & 3) == 0) for (int it = gw >> 2; it < 512; it += (NGW >> 2)) p0_wcomb_item(F, it);
    if ((gw & 3) == 2) for (int it = gw >> 2; it < BATCH * 33; it += (NGW >> 2)) p0_zf_item(F, it);
    constexpr int I_IN = (D / 64) * (NZ / 32), I_OUT = (VAL / 64) * (D / 32), I_GU = (D / 64) * (NGU / 32), I_D = (FF / 64) * (D / 32), I_PG = (D / 64) * (D / 32), I_PP = (DPLE / 64) * (D / 32);
    constexpr int NITEMS = I_IN + I_OUT + I_GU + I_D + I_PG + I_PP;
    for (int it = gw; it < NITEMS; it += NGW) {
        int r = it;
        if (r < I_IN) { const int nblk = NZ / 32; const int n0 = 32 * (r % nblk); p0_transpose_item(SrcGain{F.w_in, DIN, F.ln_mix, n0 < 1536 ? 0 : 16}, D, F.Win_t, 64 * (r / nblk), n0, scr, lane); continue; } r -= I_IN;
        if (r < I_OUT) { const int nblk = D / 32; p0_transpose_item(SrcPlain{F.w_out, D}, D, F.Wout_t, 64 * (r / nblk), 32 * (r % nblk), scr, lane); continue; } r -= I_OUT;
        if (r < I_GU) { const int nblk = NGU / 32; const int n0 = 32 * (r % nblk), j = n0 >> 8, rr = n0 & 255;
            if (rr < 128) p0_transpose_item(SrcGain{F.w_gate, FF, F.ln_ffn, -128 * j}, D, F.Wgu_t, 64 * (r / nblk), n0, scr, lane);
            else p0_transpose_item(SrcGain{F.w_up, FF, F.ln_ffn, -128 * j - 128}, D, F.Wgu_t, 64 * (r / nblk), n0, scr, lane);
            continue; } r -= I_GU;
        if (r < I_D) { const int nblk = D / 32; p0_transpose_item(SrcPlain{F.w_down, D}, FF, F.Wd_t, 64 * (r / nblk), 32 * (r % nblk), scr, lane); continue; } r -= I_D;
        if (r < I_PG) { const int nblk = D / 32; p0_transpose_item(SrcGain{F.w_pg, D, F.ln_ple, 0}, D, F.Wpg_t, 64 * (r / nblk), 32 * (r % nblk), scr, lane); continue; } r -= I_PG;
        { const int nblk = D / 32; p0_transpose_item(SrcPlain{F.w_pp, D}, DPLE, F.Wpp_t, 64 * (r / nblk), 32 * (r % nblk), scr, lane); }
    }
    for (int t = gw; t < M / 16; t += NGW) p0_x_task(F, t);
    for (size_t i = (size_t)(F.vcu * NWAVES * 64 + tid); i < (size_t)M * DPLE / 8; i += (size_t)F.G * NWAVES * 64) {
        const f32x4 a0 = *(const f32x4*)(F.p + 8 * i), a1 = *(const f32x4*)(F.p + 8 * i + 4);
        v4u w; w.x = pk2(a0[0], a0[1]); w.y = pk2(a0[2], a0[3]); w.z = pk2(a1[0], a1[1]); w.w = pk2(a1[2], a1[3]);
        *(GAS v4u*)(F.PB + 8 * i) = w;
    }
}

#ifndef DIAG_MODE
#define DIAG_MODE 0
#endif
constexpr int CW_DIAG = 100000;
template <bool CMP>
__device__ __forceinline__ void p2_gla_simple_t(Frame& F, int bh) {
    const int b = bh >> 2, h = bh & 3, tid = my_tid(), lane = tid & 63;
    LAS float* sq = (LAS float*)(F.lds); LAS float* sk = sq + 64; LAS float* sa = sk + 64; LAS float* red = sa + 64;
    float S[DK]; float wgc[RANK]; float bg = 0.f, gn = 0.f;
#pragma unroll
    for (int d = 0; d < DK; ++d) S[d] = 0.f;
#pragma unroll
    for (int r = 0; r < RANK; ++r) wgc[r] = (tid < 64) ? F.w_gate_lr[r * KEY + h * DK + tid] : 0.f;
    if (tid < 64) bg = F.b_gate[h * DK + tid];
    if (tid < 128) gn = F.gla_norm[tid];
    for (int t = 0; t < T; ++t) {
        const size_t m = (size_t)b * T + t;
        if (tid < 64) {
            float pre = bg;
#pragma unroll
            for (int r = 0; r < RANK; ++r) pre = fmaf(F.glr[m * RANK + r], wgc[r], pre);
            const float ls = fminf(pre, 0.f) - log1pf(expf(-fabsf(pre)));
            sa[tid] = expf(ls * (1.0f / 16.0f));
            sq[tid] = bf2f(F.Z[m * NZ + ZQ + h * DK + tid]) * 0.125f;
            sk[tid] = bf2f(F.Z[m * NZ + ZK + h * DK + tid]);
        }
        __syncthreads();
        float o = 0.f;
        if (tid < 128) {
            const float vv = bf2f(F.Z[m * NZ + ZV + h * DV + tid]);
#pragma unroll
            for (int d = 0; d < DK; ++d) { S[d] = fmaf(sa[d], S[d], sk[d] * vv); o = fmaf(sq[d], S[d], o); }
            const float s2 = wave_sum(o * o);
            if (lane == 0) red[F.wave] = s2;
        }
        __syncthreads();
        if (tid < 128) {
            const float rstd = 1.0f / sqrtf((red[0] + red[1]) * (1.0f / DV) + EPS);
            const float g = bf2f(F.Z[m * NZ + ZG + h * DV + tid]);
            const float val = o * rstd * gn * (g / (1.0f + expf(-g)));
            if (!CMP) F.A2[m * D + h * DV + tid] = (bf16)f2bf(val);
            else if (t >= TFIX) { const float df = fabsf(val - bf2f(F.A2[m * D + h * DV + tid]));
                const int cat = (DIAG_MODE == 1) ? (t & 63) : (DIAG_MODE == 2) ? (t >> 6) : (DIAG_MODE == 3) ? (tid >> 1) : (DIAG_MODE == 4) ? bh : 0;
                atomicMax((unsigned*)(F.ctl + CW_DIAG) + cat, __float_as_uint(df)); }
        }
    }
}
__device__ __forceinline__ void p2_gla_simple(Frame& F, int bh) { p2_gla_simple_t<false>(F, bh); }
__device__ __forceinline__ void p2_gla_fix(Frame& F, int bh) {
    const int b = bh >> 2, h = bh & 3, tid = my_tid(), lane = tid & 63;
    LAS float* sq = (LAS float*)(F.lds); LAS float* sk = sq + 64; LAS float* sa = sk + 64; LAS float* red = sa + 64;
    float S[DK]; float wgc[RANK]; float bg = 0.f, gn = 0.f;
#pragma unroll
    for (int d = 0; d < DK; ++d) S[d] = 0.f;
#pragma unroll
    for (int r = 0; r < RANK; ++r) wgc[r] = (tid < 64) ? F.w_gate_lr[r * KEY + h * DK + tid] : 0.f;
    if (tid < 64) bg = F.b_gate[h * DK + tid];
    if (tid < 128) gn = F.gla_norm[tid];
    __syncthreads();
    for (int t = 0; t < TFIX; ++t) {
        const float* zr = F.zf + (size_t)(b * TFIX + t) * DIN; const size_t m = (size_t)b * T + t;
        if (tid < 64) {
            float pre = bg;
#pragma unroll
            for (int r = 0; r < RANK; ++r) pre = fmaf(zr[1536 + r], wgc[r], pre);
            const float ls = fminf(pre, 0.f) - log1pf(expf(-fabsf(pre)));
            sa[tid] = expf(ls * (1.0f / 16.0f));
            sq[tid] = zr[h * DK + tid] * 0.125f;
            sk[tid] = zr[256 + h * DK + tid];
        }
        __syncthreads();
        float o = 0.f;
        if (tid < 128) {
            const float vv = zr[512 + h * DV + tid];
#pragma unroll
            for (int d = 0; d < DK; ++d) { S[d] = fmaf(sa[d], S[d], sk[d] * vv); o = fmaf(sq[d], S[d], o); }
            const float s2 = wave_sum(o * o);
            if (lane == 0) red[F.wave] = s2;
        }
        __syncthreads();
        if (tid < 128) {
            const float rstd = 1.0f / sqrtf((red[0] + red[1]) * (1.0f / DV) + EPS);
            const float g = zr[1024 + h * DV + tid];
            const float val = o * rstd * gn * (g / (1.0f + expf(-g)));
            F.A2[m * D + h * DV + tid] = (bf16)f2bf(val);
        }
    }
}
typedef float f32x16 __attribute__((ext_vector_type(16)));
typedef short v4i16_t __attribute__((ext_vector_type(4)));
typedef float f32x2_t __attribute__((ext_vector_type(2))); typedef __bf16 bf16x2_t __attribute__((ext_vector_type(2)));
__device__ __forceinline__ unsigned cvtpk_c(float lo, float hi) { f32x2_t v = {lo, hi}; bf16x2_t bb = __builtin_convertvector(v, bf16x2_t); return __builtin_bit_cast(unsigned, bb); }
typedef unsigned u32x2 __attribute__((ext_vector_type(2)));
constexpr int G_QE = 0, G_KE = 9216, G_KD = 18432, G_VB = 30720, G_OT = 71680, G_EL = 105472, G_END = 105728;
constexpr int QK_P = 144, KD_P = 192, V_P = 320, OT_P = 528, VB_BYTES = 64 * V_P;
static_assert(G_KE == G_QE + 64 * QK_P && G_KD == G_KE + 64 * QK_P && G_VB == G_KD + 64 * KD_P && G_OT == G_VB + 2 * VB_BYTES && G_EL == G_OT + 64 * OT_P && G_END <= RING_BYTES, "GLA LDS map");
#define GLA_BAR() do { asm volatile("s_waitcnt lgkmcnt(0)" ::: "memory"); __builtin_amdgcn_s_barrier(); asm volatile("" ::: "memory"); } while (0)
__device__ __forceinline__ float dpp_shr(float v, int n) {
    const int iv = __builtin_bit_cast(int, v); int r;
    switch (n) { case 1: r = __builtin_amdgcn_update_dpp(0, iv, 0x111, 0xf, 0xf, true); break; case 2: r = __builtin_amdgcn_update_dpp(0, iv, 0x112, 0xf, 0xf, true); break;
                 case 4: r = __builtin_amdgcn_update_dpp(0, iv, 0x114, 0xf, 0xf, true); break; default: r = __builtin_amdgcn_update_dpp(0, iv, 0x118, 0xf, 0xf, true); break; }
    return __builtin_bit_cast(float, r);
}
__device__ __forceinline__ bf16x8 tr8(const LAS unsigned char* p0, const LAS unsigned char* p1) {
    const v4i16_t a = __builtin_amdgcn_ds_read_tr16_b64_v4i16((LAS v4i16_t*)p0), b = __builtin_amdgcn_ds_read_tr16_b64_v4i16((LAS v4i16_t*)p1);
    bf16x8 r; r[0] = a[0]; r[1] = a[1]; r[2] = a[2]; r[3] = a[3]; r[4] = b[0]; r[5] = b[1]; r[6] = b[2]; r[7] = b[3]; return r;
}
__device__ __forceinline__ bf16x8 cvt8(const f32x16& x, int s) {
    v4u w; w.x = cvtpk_c(x[8 * s + 0], x[8 * s + 1]); w.y = cvtpk_c(x[8 * s + 2], x[8 * s + 3]); w.z = cvtpk_c(x[8 * s + 4], x[8 * s + 5]); w.w = cvtpk_c(x[8 * s + 6], x[8 * s + 7]);
    return __builtin_bit_cast(bf16x8, w);
}
#define MFMA32(a, b, c) __builtin_amdgcn_mfma_f32_32x32x16_bf16((a), (b), (c), 0, 0, 0)
__device__ __forceinline__ void p2_gla_chunked(Frame& F, int bh) {
    const int b = bh >> 2, h = bh & 3, tid = my_tid(), lane = tid & 63, wave = F.wave;
    const LAS unsigned char* L = F.lds;
    constexpr int NCH = T / 64;
    const size_t mb = (size_t)b * T;
    if (wave < 4) {
        const int w = wave, g4 = lane >> 4, tl = lane & 15, r = lane & 31, hh = lane >> 5;
        bf16x8 wgA;
#pragma unroll
        for (int j = 0; j < 8; ++j) wgA[j] = (g4 < 2) ? (short)f2bf(F.w_gate_lr[(8 * g4 + j) * KEY + h * DK + 16 * w + tl]) : (short)0;
        float bg4[4];
#pragma unroll
        for (int e = 0; e < 4; ++e) bg4[e] = F.b_gate[h * DK + 16 * w + 4 * g4 + e];
        const int pos_nat = 16 * w + 4 * g4, pos_perm = 16 * w + 8 * (g4 & 1) + 4 * (g4 >> 1);
        u32x2 qr[4], kr[4]; bf16x8 gB[4];
        auto prefetch = [&](int n) {
#pragma unroll
            for (int tile = 0; tile < 4; ++tile) { const size_t m = mb + 64 * n + 16 * tile + tl;
                qr[tile] = *(const GAS u32x2*)(F.Z + m * NZ + ZQ + h * DK + pos_nat);
                kr[tile] = *(const GAS u32x2*)(F.Z + m * NZ + ZK + h * DK + pos_nat);
                if (g4 < 2) gB[tile] = *(const GAS bf16x8*)(F.glrb + m * RANK + 8 * g4); else gB[tile] = (bf16x8){0, 0, 0, 0, 0, 0, 0, 0}; }
        };
        prefetch(0);
        f32x16 S0, S1;
#pragma unroll
        for (int e = 0; e < 16; ++e) { S0[e] = 0.f; S1[e] = 0.f; }
        const int qe_frag = (r * QK_P) + 16 * hh;
        const int trq = (tl >> 2), trp = (tl & 3), gsel = g4 & 1;
        const int v_tr = (4 * hh + trq) * V_P + (32 * w + 16 * gsel + 4 * trp) * 2;
        const int kd_tr = (4 * hh + trq) * KD_P + (16 * gsel + 4 * trp) * 2;
        for (int n = 0; n < NCH; ++n) {
            float bcar[4] = {0.f, 0.f, 0.f, 0.f}; float bv[4][4];
#pragma unroll
            for (int tile = 0; tile < 4; ++tile) {
                const f32x4 pre = __builtin_amdgcn_mfma_f32_16x16x32_bf16(wgA, gB[tile], (f32x4){0.f, 0.f, 0.f, 0.f}, 0, 0, 0);
#pragma unroll
                for (int e = 0; e < 4; ++e) {
                    const float x = pre[e] + bg4[e];
                    const float ex = __builtin_amdgcn_exp2f(-1.44269504f * fabsf(x));
                    float s = (fminf(x, 0.f) - 0.693147181f * __builtin_amdgcn_logf(1.0f + ex)) * (1.0f / 16.0f);
                    s += dpp_shr(s, 1); s += dpp_shr(s, 2); s += dpp_shr(s, 4); s += dpp_shr(s, 8);
                    s += bcar[e]; bv[tile][e] = s;
                    bcar[e] = __shfl(s, (lane & 48) | 15);
                }
            }
            float eL[4];
#pragma unroll
            for (int e = 0; e < 4; ++e) eL[e] = __builtin_amdgcn_exp2f(1.44269504f * bcar[e]);
            if (tl == 0) *(LAS f32x4*)(L + G_EL + (16 * w + 4 * g4) * 4) = (f32x4){eL[0], eL[1], eL[2], eL[3]};
#pragma unroll
            for (int tile = 0; tile < 4; ++tile) {
                const int t = 16 * tile + tl;
                const float qf[4] = {pg8::bf_lo(qr[tile].x), pg8::bf_hi(qr[tile].x), pg8::bf_lo(qr[tile].y), pg8::bf_hi(qr[tile].y)};
                const float kf[4] = {pg8::bf_lo(kr[tile].x), pg8::bf_hi(kr[tile].x), pg8::bf_lo(kr[tile].y), pg8::bf_hi(kr[tile].y)};
                float qe[4], ke[4], kd[4];
#pragma unroll
                for (int e = 0; e < 4; ++e) { const float e1 = __builtin_amdgcn_exp2f(1.44269504f * bv[tile][e]), e2 = __builtin_amdgcn_rcpf(e1);
                    qe[e] = qf[e] * 0.125f * e1; ke[e] = kf[e] * e2; kd[e] = ke[e] * eL[e]; }
                u32x2 o;
                o.x = cvtpk_c(qe[0], qe[1]); o.y = cvtpk_c(qe[2], qe[3]); *(LAS u32x2*)(L + G_QE + t * QK_P + pos_perm * 2) = o;
                o.x = cvtpk_c(ke[0], ke[1]); o.y = cvtpk_c(ke[2], ke[3]); *(LAS u32x2*)(L + G_KE + t * QK_P + pos_perm * 2) = o;
                o.x = cvtpk_c(kd[0], kd[1]); o.y = cvtpk_c(kd[2], kd[3]); *(LAS u32x2*)(L + G_KD + t * KD_P + pos_nat * 2) = o;
            }
            GLA_BAR();
            if (n + 1 < NCH) prefetch(n + 1);
            const LAS unsigned char* vb = L + G_VB + (n & 1) * VB_BYTES;
            bf16x8 qeF[2][4];
#pragma unroll
            for (int it = 0; it < 2; ++it)
#pragma unroll
                for (int s = 0; s < 4; ++s) qeF[it][s] = *(const LAS bf16x8*)(L + G_QE + qe_frag + 32 * it * QK_P + 32 * s);
            f32x16 O0, O1;
#pragma unroll
            for (int e = 0; e < 16; ++e) { O0[e] = 0.f; O1[e] = 0.f; }
            { const bf16x8 sb00 = cvt8(S0, 0), sb01 = cvt8(S0, 1), sb10 = cvt8(S1, 0), sb11 = cvt8(S1, 1);
              O0 = MFMA32(qeF[0][0], sb00, O0); O1 = MFMA32(qeF[1][0], sb00, O1);
              O0 = MFMA32(qeF[0][1], sb01, O0); O1 = MFMA32(qeF[1][1], sb01, O1);
              O0 = MFMA32(qeF[0][2], sb10, O0); O1 = MFMA32(qeF[1][2], sb10, O1);
              O0 = MFMA32(qeF[0][3], sb11, O0); O1 = MFMA32(qeF[1][3], sb11, O1); }
            bf16x8 vF[2][2];
#pragma unroll
            for (int jt = 0; jt < 2; ++jt)
#pragma unroll
                for (int s = 0; s < 2; ++s) { const LAS unsigned char* p = vb + v_tr + (32 * jt + 16 * s) * V_P; vF[jt][s] = tr8(p, p + 8 * V_P); }
            { bf16x8 keF[4];
#pragma unroll
              for (int s = 0; s < 4; ++s) keF[s] = *(const LAS bf16x8*)(L + G_KE + qe_frag + 32 * s);
              f32x16 X;
#pragma unroll
              for (int e = 0; e < 16; ++e) X[e] = 0.f;
#pragma unroll
              for (int s = 0; s < 4; ++s) X = MFMA32(keF[s], qeF[0][s], X);
#pragma unroll
              for (int e = 0; e < 16; ++e) { const int jl = (e & 3) + 8 * (e >> 2) + 4 * hh; X[e] = (jl <= r) ? X[e] : 0.f; }
              O0 = MFMA32(cvt8(X, 0), vF[0][0], O0); O0 = MFMA32(cvt8(X, 1), vF[0][1], O0);
#pragma unroll
              for (int e = 0; e < 16; ++e) X[e] = 0.f;
#pragma unroll
              for (int s = 0; s < 4; ++s) X = MFMA32(keF[s], qeF[1][s], X);
              O1 = MFMA32(cvt8(X, 0), vF[0][0], O1); O1 = MFMA32(cvt8(X, 1), vF[0][1], O1);
#pragma unroll
              for (int s = 0; s < 4; ++s) keF[s] = *(const LAS bf16x8*)(L + G_KE + qe_frag + 32 * QK_P + 32 * s);
#pragma unroll
              for (int e = 0; e < 16; ++e) X[e] = 0.f;
#pragma unroll
              for (int s = 0; s < 4; ++s) X = MFMA32(keF[s], qeF[1][s], X);
#pragma unroll
              for (int e = 0; e < 16; ++e) { const int jl = (e & 3) + 8 * (e >> 2) + 4 * hh; X[e] = (jl <= r) ? X[e] : 0.f; }
              O1 = MFMA32(cvt8(X, 0), vF[1][0], O1); O1 = MFMA32(cvt8(X, 1), vF[1][1], O1); }
            {
#pragma unroll
              for (int q4 = 0; q4 < 4; ++q4) { const f32x4 e0 = *(const LAS f32x4*)(L + G_EL + (8 * q4 + 4 * hh) * 4), e1 = *(const LAS f32x4*)(L + G_EL + (32 + 8 * q4 + 4 * hh) * 4);
#pragma unroll
                  for (int e = 0; e < 4; ++e) { S0[4 * q4 + e] *= e0[e]; S1[4 * q4 + e] *= e1[e]; } }
#pragma unroll
              for (int jt = 0; jt < 2; ++jt)
#pragma unroll
                  for (int s = 0; s < 2; ++s) { const LAS unsigned char* p = L + G_KD + kd_tr + (32 * jt + 16 * s) * KD_P;
                      S0 = MFMA32(tr8(p, p + 8 * KD_P), vF[jt][s], S0); S1 = MFMA32(tr8(p + 64, p + 64 + 8 * KD_P), vF[jt][s], S1); } }
#pragma unroll
            for (int e = 0; e < 16; ++e) { const int i = (e & 3) + 8 * (e >> 2) + 4 * hh;
                *(LAS float*)(L + G_OT + i * OT_P + (32 * w + r) * 4) = O0[e]; *(LAS float*)(L + G_OT + (32 + i) * OT_P + (32 * w + r) * 4) = O1[e]; }
            GLA_BAR();
        }
    } else {
        const int hw = wave - 4, ro = 16 * hw + (lane >> 2), qd = lane & 3;
        float gn[32];
#pragma unroll
        for (int i = 0; i < 32; ++i) gn[i] = F.gla_norm[32 * qd + i];
        const int vrow = 4 * hw + (lane >> 4), vpc = lane & 15;
        v4u vst[4];
        auto vload = [&](int n) {
#pragma unroll
            for (int ps = 0; ps < 4; ++ps) vst[ps] = *(const GAS v4u*)(F.Z + (mb + 64 * n + 16 * ps + vrow) * NZ + ZV + h * DV + 8 * vpc);
        };
        auto vwrite = [&](int n) {
#pragma unroll
            for (int ps = 0; ps < 4; ++ps) *(LAS v4u*)(L + G_VB + (n & 1) * VB_BYTES + (16 * ps + vrow) * V_P + 16 * vpc) = vst[ps];
        };
        auto output = [&](int c) {
            const size_t m = mb + 64 * c + ro;
            v4u gw4[4];
#pragma unroll
            for (int i = 0; i < 4; ++i) gw4[i] = *(const GAS v4u*)(F.Z + m * NZ + ZG + h * DV + 32 * qd + 8 * i);
            f32x4 o[8]; float ss = 0.f;
#pragma unroll
            for (int i = 0; i < 8; ++i) { o[i] = *(const LAS f32x4*)(L + G_OT + ro * OT_P + (32 * qd + 4 * i) * 4); ss += (o[i][0] * o[i][0] + o[i][1] * o[i][1]) + (o[i][2] * o[i][2] + o[i][3] * o[i][3]); }
            ss += __shfl_xor(ss, 1); ss += __shfl_xor(ss, 2);
            const float rstd = 1.0f / sqrtf(ss * (1.0f / DV) + EPS);
            v4u ow[4];
#pragma unroll
            for (int i = 0; i < 4; ++i) { const unsigned gwv[4] = {gw4[i].x, gw4[i].y, gw4[i].z, gw4[i].w}; unsigned pk[4];
#pragma unroll
                for (int e = 0; e < 4; ++e) { const float g0 = pg8::bf_lo(gwv[e]), g1 = pg8::bf_hi(gwv[e]); const int c0 = 8 * i + 2 * e;
                    const float v0 = o[c0 >> 2][c0 & 3] * rstd * gn[c0] * (g0 * pg8::sigmoid_f(g0)), v1 = o[(c0 + 1) >> 2][(c0 + 1) & 3] * rstd * gn[c0 + 1] * (g1 * pg8::sigmoid_f(g1));
                    pk[e] = cvtpk_c(v0, v1); }
                ow[i] = (v4u){pk[0], pk[1], pk[2], pk[3]}; }
            if (!(c == 0 && ro < TFIX)) {
#pragma unroll
                for (int i = 0; i < 4; ++i) *(GAS v4u*)(F.A2 + m * D + h * DV + 32 * qd + 8 * i) = ow[i]; }
        };
        vload(0); vwrite(0);
        for (int n = 0; n < NCH; ++n) {
            if (n + 1 < NCH) vload(n + 1);
            if (n > 0) output(n - 1);
            GLA_BAR();
            if (n + 1 < NCH) vwrite(n + 1);
            GLA_BAR();
        }
        output(NCH - 1);
    }
    __syncthreads();
}
__device__ __forceinline__ void p2_pool_simple(Frame& F, int start, int stride) {
    for (int i = start; i < M * (POOLW / 8); i += stride) {
        const int m = i >> 6, c8 = i & 63, c = c8 * 8, t = m & (T - 1), g = c >> 7;
        const int w = 2 << g, cnt = (t + 1 < w) ? (t + 1) : w;
        float s[8];
#pragma unroll
        for (int e = 0; e < 8; ++e) s[e] = 0.f;
        float u0[8];
        for (int j = 0; j < cnt; ++j) {
            const v4u pw = *(const GAS v4u*)(F.Z + (size_t)(m - j) * NZ + ZU + c);
            const float v[8] = {pg8::bf_lo(pw.x), pg8::bf_hi(pw.x), pg8::bf_lo(pw.y), pg8::bf_hi(pw.y), pg8::bf_lo(pw.z), pg8::bf_hi(pw.z), pg8::bf_lo(pw.w), pg8::bf_hi(pw.w)};
#pragma unroll
            for (int e = 0; e < 8; ++e) { s[e] += v[e]; if (j == 0) u0[e] = v[e]; }
        }
        const float inv = 1.0f / (float)cnt;
        v4u o; o.x = pk2(s[0] * inv - u0[0], s[1] * inv - u0[1]); o.y = pk2(s[2] * inv - u0[2], s[3] * inv - u0[3]);
        o.z = pk2(s[4] * inv - u0[4], s[5] * inv - u0[5]); o.w = pk2(s[6] * inv - u0[6], s[7] * inv - u0[7]);
        *(GAS v4u*)(F.A2 + (size_t)m * D + VAL + c) = o;
    }
}
__device__ __forceinline__ void p7_final(Frame& F) {
    const int gw = F.vcu * NWAVES + F.wave, NGW = F.G * NWAVES, lane = my_tid() & 63;
    f32x4 gv[4];
#pragma unroll
    for (int j = 0; j < 4; ++j) gv[j] = *(const f32x4*)(F.ln_final + 4 * lane + 256 * j);
    for (int m = gw; m < M; m += NGW) {
        float s = (lane < 16) ? F.ssq3[(size_t)m * 16 + lane] : 0.f;
        s = wave_sum(s);
        const float rstd = 1.0f / sqrtf(s * (1.0f / D) + EPS);
        GAS f32x4* o = (GAS f32x4*)(F.out + (size_t)m * D) + lane;
#pragma unroll
        for (int j = 0; j < 4; ++j) { f32x4 v = o[64 * j]; v = v * rstd * gv[j]; o[64 * j] = v; }
    }
}

struct Args { const float* in[18]; float* out; unsigned char* ws; int ph_lo, ph_hi, li, pad; };
__global__ void __launch_bounds__(NWAVES * 64, 2) mk_fwd(Args args) {
    extern __shared__ __attribute__((aligned(16))) unsigned char lds[];
    Frame F;
    F.lds = (LAS unsigned char*)lds;
    F.MISC = (volatile LAS unsigned*)(F.lds + MISC_OFF);
    F.wave = __builtin_amdgcn_readfirstlane((int)threadIdx.x >> 6);
    F.G = gridDim.x; { const int bx = blockIdx.x; F.vcu = (F.G % 8 == 0) ? (bx % 8) * (F.G / 8) + bx / 8 : bx; }
    unsigned char* ws = args.ws;
    F.ctl = (gu32*)(ws + WS_CTL);
    F.x = args.in[0]; F.p = args.in[1]; F.ln_mix = args.in[2]; F.w_in = args.in[3]; F.w_gate_lr = args.in[4]; F.b_gate = args.in[5]; F.gla_norm = args.in[6];
    F.w_pool = args.in[7]; F.pool_scale = args.in[8]; F.w_out = args.in[9]; F.ln_ffn = args.in[10]; F.w_gate = args.in[11]; F.w_up = args.in[12]; F.w_down = args.in[13];
    F.ln_ple = args.in[14]; F.w_pg = args.in[15]; F.w_pp = args.in[16]; F.ln_final = args.in[17]; F.out = args.out;
    F.Win_t = (bf16*)(ws + WS_WIN); F.Wout_t = (bf16*)(ws + WS_WOUT); F.Wgu_t = (bf16*)(ws + WS_WGU); F.Wd_t = (bf16*)(ws + WS_WD); F.Wpg_t = (bf16*)(ws + WS_WPG); F.Wpp_t = (bf16*)(ws + WS_WPP);
    F.zf = (float*)(ws + WS_ZF); F.glrb = (bf16*)(ws + WS_GLRB); F.rsx = (float*)(ws + WS_RSX); F.glr = (float*)(ws + WS_GLR); F.ssq1 = (float*)(ws + WS_SSQ1); F.ssq2 = (float*)(ws + WS_SSQ2); F.ssq3 = (float*)(ws + WS_SSQ3);
    F.XB = (bf16*)(ws + WS_XB); F.Z = (bf16*)(ws + WS_Z); F.ACT = (bf16*)(ws + WS_ACT); F.A2 = (bf16*)(ws + WS_A2); F.H2B = (bf16*)(ws + WS_H2B);
    F.H1B = (bf16*)(ws + WS_H1B); F.PP = (bf16*)(ws + WS_PP); F.PB = (bf16*)(ws + WS_PB);
    for (int u = threadIdx.x; u < (LDS_BYTES - LDSCTL_OFF) / 4; u += NWAVES * 64) ((LAS unsigned*)(F.lds + LDSCTL_OFF))[u] = 0u;
    __syncthreads();
    XcdBarrier bar; bar.bar = (unsigned*)(F.ctl + CW_BAR); bar.x = 0; bar.st = nullptr;
    if (N_LAUNCHES == 1) bar = xcd_barrier_post((unsigned*)(F.ctl + CW_BAR), F.MISC + 8);
#define GRID_BAR(seam) do { if (N_LAUNCHES != 1) { if (threadIdx.x == 0) __hip_atomic_store(F.ctl + CW_TMO, 0xBADBA0u | (unsigned)(seam), RLX_AGENT); } else { xcd_barrier(bar); } } while (0)
    const int lo = args.ph_lo, hi = args.ph_hi;
#ifndef PHASE_MASK
#define PHASE_MASK 0xff
#endif
#define IN(k) (((PHASE_MASK >> (k)) & 1) && lo <= (k) && (k) < hi)
#define BOTH(k) (IN(k) && IN((k) + 1))

    if (IN(0)) { p0_prologue(F); if (BOTH(0)) GRID_BAR(0); }

    if (IN(1)) {
        pg8::Gemm g{F.XB, F.Win_t, M, NZ, D}; pg8::StaticOrder S; S.init(M, NZ, F.G, (int)blockIdx.x);
        pg8::EpiScaleBf16 E{F.Z, NZ, F.rsx};
        pg8::gemm_phase<pg8::EpiScaleBf16, pg8::StaticOrder, PG8_ALIGN, PG8_SP2>(F.lds + RING_OFF, g, S, E);
        if (BOTH(1)) GRID_BAR(1);
    }

    if (IN(2)) {
        if ((int)blockIdx.x < 64 || F.G < 128) { for (int bh = blockIdx.x; bh < BATCH * NH; bh += F.G) {
#ifdef GLA_SIMPLE
                p2_gla_simple(F, bh);
#else
                p2_gla_chunked(F, bh);
#endif
                p2_gla_fix(F, bh);
#if DIAG_MODE
                __syncthreads(); p2_gla_simple_t<true>(F, bh);
#endif
            } }
        if (F.G < 128) p2_pool_simple(F, (int)blockIdx.x * NWAVES * 64 + my_tid(), F.G * NWAVES * 64);
        else if ((int)blockIdx.x >= 64) p2_pool_simple(F, ((int)blockIdx.x - 64) * NWAVES * 64 + my_tid(), (F.G - 64) * NWAVES * 64);
        if (BOTH(2)) GRID_BAR(2);
    }

    if (IN(3)) {
        pg8::Gemm g{F.A2, F.Wout_t, M, D, D}; pg8::StaticOrder S; S.init(M, D, F.G, (int)blockIdx.x);
        pg8::EpiResid E{F.x, F.out, F.H1B, F.ssq1};
        pg8::gemm_phase<pg8::EpiResid, pg8::StaticOrder, PG8_ALIGN, PG8_SP2>(F.lds + RING_OFF, g, S, E);
        if (BOTH(3)) GRID_BAR(3);
    }

    if (IN(4)) {
        pg8::Gemm g{F.H1B, F.Wgu_t, M, NGU, D}; pg8::StaticOrder S; S.init(M, NGU, F.G, (int)blockIdx.x);
        pg8::EpiSwiglu E{F.ACT, FF, F.ssq1};
        pg8::gemm_phase<pg8::EpiSwiglu, pg8::StaticOrder, PG8_ALIGN, PG8_SP2>(F.lds + RING_OFF, g, S, E);
        if (BOTH(4)) GRID_BAR(4);
    }

    if (IN(5)) {
        pg8::Gemm g{F.ACT, F.Wd_t, M, D, FF}; pg8::StaticOrder S; S.init(M, D, F.G, (int)blockIdx.x);
        pg8::EpiResid E{F.out, F.out, F.H2B, F.ssq2};
        pg8::gemm_phase<pg8::EpiResid, pg8::StaticOrder, PG8_ALIGN, PG8_SP2>(F.lds + RING_OFF, g, S, E);
        if (BOTH(5)) GRID_BAR(5);
    }

    if (IN(6)) {
#ifndef SKIP_PP
        { pg8::Gemm g{F.PB, F.Wpp_t, M, D, DPLE}; pg8::StaticOrder S; S.init(M, D, F.G, (int)blockIdx.x);
          pg8::EpiPlainBf16 E{F.PP, D};
          pg8::gemm_phase<pg8::EpiPlainBf16, pg8::StaticOrder, PG8_ALIGN, PG8_SP2>(F.lds + RING_OFF, g, S, E); }
#endif
#ifndef SKIP_PLE
        { pg8::Gemm g{F.H2B, F.Wpg_t, M, D, D}; pg8::StaticOrder S; S.init(M, D, F.G, (int)blockIdx.x);
          pg8::EpiPle E{F.out, F.PP, F.ssq2, F.ssq3};
          pg8::gemm_phase<pg8::EpiPle, pg8::StaticOrder, PG8_ALIGN, PG8_SP2>(F.lds + RING_OFF, g, S, E); }
#endif
        if (BOTH(6)) GRID_BAR(6);
    }

    if (IN(7)) { p7_final(F);
#if DIAG_MODE
        if (blockIdx.x == 0 && threadIdx.x == 0) {
            float best = 0.f; int arg = 0;
            for (int c = 0; c < 128; ++c) { const float v = __uint_as_float(__hip_atomic_load((unsigned*)(F.ctl + CW_DIAG) + c, RLX_AGENT)); if (v > best) { best = v; arg = c; } }
            asm volatile("s_waitcnt vmcnt(0)" ::: "memory");
            F.out[1] = (DIAG_MODE == 5) ? (best * 10000.f) : (best < 0.02f ? 500.f : 100.f * (float)(10 + arg));
        }
#endif
    }
#undef IN
#undef BOTH
}

extern "C" void kernel_launch(void* const* d_in, const int* in_sizes, int n_in, void* d_out, int out_size, void* d_ws, size_t ws_size, hipStream_t stream) {
    static int grid = 0;
    if (grid == 0) {
        if (n_in != 18 || in_sizes[0] != M * D || out_size != M * D || ws_size < WS_END) { fprintf(stderr, "kernel_launch: unexpected shapes (n_in %d, in0 %d, out %d, ws %zu); nothing launched\n", n_in, n_in > 0 ? in_sizes[0] : -1, out_size, ws_size); grid = -1; return; }
        int dev = 0, cus = 0, per_cu = 0;
        if (hipGetDevice(&dev) != hipSuccess || hipDeviceGetAttribute(&cus, hipDeviceAttributeMultiprocessorCount, dev) != hipSuccess) { fprintf(stderr, "kernel_launch: device query failed\n"); grid = -1; return; }
        if (hipFuncSetAttribute((const void*)mk_fwd, hipFuncAttributeMaxDynamicSharedMemorySize, LDS_BYTES) != hipSuccess) { fprintf(stderr, "kernel_launch: hipFuncSetAttribute failed\n"); grid = -1; return; }
        if (hipOccupancyMaxActiveBlocksPerMultiprocessor(&per_cu, (const void*)mk_fwd, NWAVES * 64, LDS_BYTES) != hipSuccess || per_cu < 1)
            fprintf(stderr, "kernel_launch: note: occupancy query reports %d workgroups per CU\n", per_cu);
        (void)hipGetLastError();
        grid = cus;
    }
    if (grid < 0) return;
    if (hipMemsetAsync((char*)d_ws + WS_CTL, 0, CTL_ZERO_BYTES, stream) != hipSuccess) { fprintf(stderr, "kernel_launch: hipMemsetAsync failed\n"); return; }
    Args a{};
    for (int i = 0; i < 18; ++i) a.in[i] = (const float*)d_in[i];
    a.out = (float*)d_out; a.ws = (unsigned char*)d_ws;
    for (int li = 0; li < N_LAUNCHES; ++li) {
        a.ph_lo = (N_LAUNCHES == 1) ? 0 : li; a.ph_hi = (N_LAUNCHES == 1) ? N_PHASES : li + 1; a.li = li;
        hipLaunchKernelGGL(mk_fwd, dim3(grid), dim3(NWAVES * 64), LDS_BYTES, stream, a);
        const hipError_t le = hipPeekAtLastError();
        if (le != hipSuccess) { fprintf(stderr, "kernel_launch: launch %d failed: %s\n", li, hipGetErrorName(le)); break; }
    }
}
```

```cpp
#include <hip/hip_runtime.h>
#include <cstdio>
#include <cstdint>
#define MK_N_LAUNCHES 1
namespace pg8 {
#define PG8_LAS __attribute__((address_space(3)))
typedef unsigned short bf16_t;
typedef short bf16x8 __attribute__((ext_vector_type(8)));
typedef float f32x4 __attribute__((ext_vector_type(4)));
typedef unsigned u32x4 __attribute__((ext_vector_type(4)));
constexpr int BM = 256, BK = 64, HALF = 128, HTB = HALF * BK * 2  , STAGE_BYTES = 8 * HTB, NXCD = 8, WGM = 8;

__host__ __device__ __forceinline__ int lds_byte(int r, int c) { const int st = (r >> 4) * 2 + (c >> 5), rr = r & 15, cc = c & 31, ob = rr * 64 + cc * 2; return st * 1024 + (ob ^ (((ob >> 9) & 1) << 5)); }
__host__ __device__ __forceinline__ void stage_rc(int b, int& R, int& C) { const int st = b / 1024, sb = b % 1024, swz = sb ^ (((sb >> 9) & 1) << 5); R = (st >> 1) * 16 + swz / 64; C = (st & 1) * 32 + (swz % 64) / 2; }
__host__ __device__ __forceinline__ int perm32(int rho) { const int n = rho >> 4, i = rho & 15; return 8 * (i >> 2) + 4 * n + (i & 3); }

struct Unit { int pm, pn; };
struct Gemm { const bf16_t* A; const bf16_t* Bt; int M, N, K; };

struct StaticOrder {
    int nM, nN, nwg, G, c;
    __host__ __device__ void init(int M, int N, int G_, int c_) { nM = M / BM; nN = N / BM; nwg = nM * nN; G = G_; c = c_; }
    __host__ __device__ bool next(int i, Unit& u) const {
        const long L = (long)i * G + c; if (L >= nwg) return false;
        int wgid = (int)L; { const int q = nwg / NXCD, r = nwg % NXCD, xcd = wgid % NXCD, off = wgid / NXCD; wgid = (xcd < r ? xcd * (q + 1) : r * (q + 1) + (xcd - r) * q) + off; }
        const int nig = WGM * nN, gid = wgid / nig, fm = gid * WGM, gsz = (nM - fm) < WGM ? (nM - fm) : WGM;
        u.pm = fm + ((wgid % nig) % gsz); u.pn = (wgid % nig) / gsz; return true;
    }
    __device__ __forceinline__ void a_ready(const Unit&) const {}
    __device__ __forceinline__ void done(const Unit&) const {}
};

__device__ __forceinline__ unsigned cvt_pk_bf16(float lo, float hi) { unsigned r; asm volatile("v_cvt_pk_bf16_f32 %0, %1, %2" : "=v"(r) : "v"(lo), "v"(hi)); return r; }
typedef float f32x2 __attribute__((ext_vector_type(2)));
constexpr float RMS_EPS = 1e-6f;
__device__ __forceinline__ float sigmoid_f(float x) { return __builtin_amdgcn_rcpf(1.0f + __builtin_amdgcn_exp2f(-1.44269504f * x)); }
__device__ __forceinline__ float bf_lo(unsigned w) { return __uint_as_float(w << 16); }
__device__ __forceinline__ float bf_hi(unsigned w) { return __uint_as_float(w & 0xffff0000u); }
__device__ __forceinline__ float rstd16(const float* ssq, int row) {
    const f32x4* p = (const f32x4*)(ssq + (size_t)row * 16);
    const f32x4 a = p[0], b = p[1], c = p[2], d = p[3];
    const float s = ((a[0] + a[1]) + (a[2] + a[3])) + ((b[0] + b[1]) + (b[2] + b[3])) + ((c[0] + c[1]) + (c[2] + c[3])) + ((d[0] + d[1]) + (d[2] + d[3]));
    return __builtin_amdgcn_rsqf(s * (1.0f / 1024.0f) + RMS_EPS);
}
__device__ __forceinline__ u32x4 pack8(const f32x4 v0, const f32x4 v1) { u32x4 w; w.x = cvt_pk_bf16(v0[0], v0[1]); w.y = cvt_pk_bf16(v0[2], v0[3]); w.z = cvt_pk_bf16(v1[0], v1[1]); w.w = cvt_pk_bf16(v1[2], v1[3]); return w; }

struct EpiScaleBf16 {
    static constexpr bool PERM = true, AFTER_DRAIN = false;
    bf16_t* O; int ldc; const float* rs;
    __device__ __forceinline__ void operator()(const f32x4 (&acc)[2][2][4][2], const Unit& u, int wr, int wc, int fr, int fq) const {
        const int row0 = u.pm * BM + wr * 64 + fr, col0 = u.pn * BM + wc * 32 + 8 * fq;
#pragma unroll
        for (int ai = 0; ai < 2; ++ai)
#pragma unroll
            for (int m = 0; m < 4; ++m) { const int row = row0 + ai * HALF + m * 16; const float s = rs[row]; bf16_t* rowp = O + (size_t)row * ldc + col0;
#pragma unroll
                for (int bj = 0; bj < 2; ++bj) *(u32x4*)(rowp + bj * HALF) = pack8(acc[ai][bj][m][0] * s, acc[ai][bj][m][1] * s); }
    }
};
struct EpiPlainBf16 {
    static constexpr bool PERM = true, AFTER_DRAIN = false;
    bf16_t* O; int ldc;
    __device__ __forceinline__ void operator()(const f32x4 (&acc)[2][2][4][2], const Unit& u, int wr, int wc, int fr, int fq) const {
        const int row0 = u.pm * BM + wr * 64 + fr, col0 = u.pn * BM + wc * 32 + 8 * fq;
#pragma unroll
        for (int ai = 0; ai < 2; ++ai)
#pragma unroll
            for (int m = 0; m < 4; ++m) { bf16_t* rowp = O + (size_t)(row0 + ai * HALF + m * 16) * ldc + col0;
#pragma unroll
                for (int bj = 0; bj < 2; ++bj) *(u32x4*)(rowp + bj * HALF) = pack8(acc[ai][bj][m][0], acc[ai][bj][m][1]); }
    }
};
template <bool BASE_BF16> struct EpiResid {
    static constexpr bool PERM = true, AFTER_DRAIN = false;
    const void* base; bf16_t* ob; float* ssq;
    __device__ __forceinline__ void operator()(const f32x4 (&acc)[2][2][4][2], const Unit& u, int wr, int wc, int fr, int fq) const {
        const int row0 = u.pm * BM + wr * 64 + fr, col0 = u.pn * BM + wc * 32 + 8 * fq;
#pragma unroll
        for (int ai = 0; ai < 2; ++ai)
#pragma unroll
            for (int m = 0; m < 4; ++m) { const int row = row0 + ai * HALF + m * 16; float q = 0.f;
#pragma unroll
                for (int bj = 0; bj < 2; ++bj) { const size_t off = (size_t)row * 1024 + col0 + bj * HALF;
                    f32x4 b0, b1;
                    if (BASE_BF16) { const u32x4 pw = *(const u32x4*)((const bf16_t*)base + off); b0 = (f32x4){bf_lo(pw.x), bf_hi(pw.x), bf_lo(pw.y), bf_hi(pw.y)}; b1 = (f32x4){bf_lo(pw.z), bf_hi(pw.z), bf_lo(pw.w), bf_hi(pw.w)}; }
                    else { b0 = *(const f32x4*)((const float*)base + off); b1 = *(const f32x4*)((const float*)base + off + 4); }
                    const f32x4 v0 = acc[ai][bj][m][0] + b0, v1 = acc[ai][bj][m][1] + b1;
                    *(u32x4*)(ob + off) = pack8(v0, v1);
                    q += ((v0[0] * v0[0] + v0[1] * v0[1]) + (v0[2] * v0[2] + v0[3] * v0[3])) + ((v1[0] * v1[0] + v1[1] * v1[1]) + (v1[2] * v1[2] + v1[3] * v1[3])); }
                q += __shfl_xor(q, 16); q += __shfl_xor(q, 32);
                if (fq == 0) ssq[(size_t)row * 16 + u.pn * 4 + wc] = q; }
    }
};
struct EpiSwiglu {
    static constexpr bool PERM = true, AFTER_DRAIN = false;
    bf16_t* O; int ldo; const float* ssq;
    __device__ __forceinline__ void operator()(const f32x4 (&acc)[2][2][4][2], const Unit& u, int wr, int wc, int fr, int fq) const {
        const int row0 = u.pm * BM + wr * 64 + fr, col0 = u.pn * HALF + wc * 32 + 8 * fq;
#pragma unroll
        for (int ai = 0; ai < 2; ++ai)
#pragma unroll
            for (int m = 0; m < 4; ++m) { const int row = row0 + ai * HALF + m * 16; const float rs = rstd16(ssq, row);
                f32x4 r[2];
#pragma unroll
                for (int n = 0; n < 2; ++n) { const f32x4 g = acc[ai][0][m][n] * rs, up = acc[ai][1][m][n] * rs;
#pragma unroll
                    for (int e = 0; e < 4; ++e) r[n][e] = g[e] * sigmoid_f(g[e]) * up[e]; }
                *(u32x4*)(O + (size_t)row * ldo + col0) = pack8(r[0], r[1]); }
    }
};
struct EpiPle {
    static constexpr bool PERM = true, AFTER_DRAIN = false;
    bf16_t* hb; const bf16_t* pp; const float* ssq_in; float* ssq_out;
    __device__ __forceinline__ void operator()(const f32x4 (&acc)[2][2][4][2], const Unit& u, int wr, int wc, int fr, int fq) const {
        const int row0 = u.pm * BM + wr * 64 + fr, col0 = u.pn * BM + wc * 32 + 8 * fq;
#pragma unroll
        for (int ai = 0; ai < 2; ++ai)
#pragma unroll
            for (int m = 0; m < 4; ++m) { const int row = row0 + ai * HALF + m * 16; const float rs = rstd16(ssq_in, row); float q = 0.f;
#pragma unroll
                for (int bj = 0; bj < 2; ++bj) { const size_t off = (size_t)row * 1024 + col0 + bj * HALF;
                    const u32x4 pw = *(const u32x4*)(pp + off), hw = *(const u32x4*)(hb + off);
                    const f32x4 p0 = {bf_lo(pw.x), bf_hi(pw.x), bf_lo(pw.y), bf_hi(pw.y)}, p1 = {bf_lo(pw.z), bf_hi(pw.z), bf_lo(pw.w), bf_hi(pw.w)};
                    f32x4 v0 = {bf_lo(hw.x), bf_hi(hw.x), bf_lo(hw.y), bf_hi(hw.y)}, v1 = {bf_lo(hw.z), bf_hi(hw.z), bf_lo(hw.w), bf_hi(hw.w)};
                    const f32x4 g0 = acc[ai][bj][m][0] * rs, g1 = acc[ai][bj][m][1] * rs;
#pragma unroll
                    for (int e = 0; e < 4; ++e) { v0[e] += sigmoid_f(g0[e]) * p0[e]; v1[e] += sigmoid_f(g1[e]) * p1[e]; }
                    *(u32x4*)(hb + off) = pack8(v0, v1);
                    q += ((v0[0] * v0[0] + v0[1] * v0[1]) + (v0[2] * v0[2] + v0[3] * v0[3])) + ((v1[0] * v1[0] + v1[1] * v1[1]) + (v1[2] * v1[2] + v1[3] * v1[3])); }
                q += __shfl_xor(q, 16); q += __shfl_xor(q, 32);
                if (fq == 0) ssq_out[(size_t)row * 16 + u.pn * 4 + wc] = q;
                asm volatile("" ::: "memory"); }
    }
};

template <class Epi, class Sched, bool ALIGN_EPI = false, bool SP2 = false>
__device__ __forceinline__ void gemm_phase(PG8_LAS unsigned char* lds, const Gemm g, const Sched& S, const Epi& E) {
    int tid_ = threadIdx.x; asm volatile("" : "+v"(tid_));
    const int tid = tid_, wid = __builtin_amdgcn_readfirstlane(tid >> 6), lane = tid & 63, wr = wid >> 2, wc = wid & 3, fr = lane & 15, fq = lane >> 4;
    const int K = g.K, nt = K / BK;
    unsigned voffA[2], voffB[2];
#pragma unroll
    for (int i = 0; i < 2; ++i) { int R, C; stage_rc(tid * 16 + i * 8192, R, C); const int Rb = Epi::PERM ? ((R & ~31) + perm32(R & 31)) : R;
        voffA[i] = (unsigned)(R * K + C) * 2u; voffB[i] = (unsigned)(Rb * K + C) * 2u; }
    const size_t kstep = (size_t)(BK * 2);
    const size_t hstep = (size_t)HALF * K * 2;
    const size_t tstep = 2 * hstep;
    const unsigned ldsw = (unsigned)wid * 1024u;
    const int aoff = lds_byte(wr * 64 + fr, fq * 8), boff = lds_byte(wc * 32 + fr, fq * 8);
#define PG8_SA(b, h) (((b) * 2 + (h)) * HTB)
#define PG8_SB(b, h) ((4 + (b) * 2 + (h)) * HTB)
#define PG8_STAGE(bufoff, gbase, voff) do { _Pragma("unroll") for (int _i = 0; _i < 2; ++_i) \
        __builtin_amdgcn_global_load_lds((const unsigned*)((const char*)(gbase) + (voff)[_i]), (PG8_LAS unsigned*)(lds + (bufoff) + ldsw + _i * 8192), 16, 0, 0); } while (0)
#define PG8_LDA(dst, b, h) do { _Pragma("unroll") for (int m = 0; m < 4; ++m) _Pragma("unroll") for (int k = 0; k < 2; ++k) dst[m][k] = *(const PG8_LAS bf16x8*)(lds + PG8_SA(b, h) + aoff + m * 2048 + k * 1024); } while (0)
#define PG8_LDB(dst, b, h) do { _Pragma("unroll") for (int n = 0; n < 2; ++n) _Pragma("unroll") for (int k = 0; k < 2; ++k) dst[n][k] = *(const PG8_LAS bf16x8*)(lds + PG8_SB(b, h) + boff + n * 2048 + k * 1024); } while (0)
#define PG8_MMA(ai, bj, At, Bt) do { __builtin_amdgcn_s_setprio(1); _Pragma("unroll") for (int m = 0; m < 4; ++m) _Pragma("unroll") for (int n = 0; n < 2; ++n) _Pragma("unroll") for (int k = 0; k < 2; ++k) \
        acc[ai][bj][m][n] = __builtin_amdgcn_mfma_f32_16x16x32_bf16(Bt[n][k], At[m][k], acc[ai][bj][m][n], 0, 0, 0); __builtin_amdgcn_s_setprio(0); } while (0)
#define PG8_WAIT_V(n) asm volatile("s_waitcnt vmcnt(" #n ")" ::: "memory")
#define PG8_WAIT_L(n) asm volatile("s_waitcnt lgkmcnt(" #n ")" ::: "memory")
#define PG8_BAR __builtin_amdgcn_s_barrier()
#define PG8_SCHED __builtin_amdgcn_sched_barrier(0)
    Unit cur, nxt; int ui = 0;
    if (!S.next(0, cur)) return;
    f32x4 acc[2][2][4][2];
#pragma unroll
    for (int a = 0; a < 2; ++a)
#pragma unroll
        for (int b = 0; b < 2; ++b)
#pragma unroll
            for (int m = 0; m < 4; ++m)
#pragma unroll
                for (int n = 0; n < 2; ++n) acc[a][b][m][n] = (f32x4){0.f, 0.f, 0.f, 0.f};
    bf16x8 At[4][2], B0[2][2], B1[2][2];
    const char* cA = (const char*)g.A + (size_t)cur.pm * tstep; const char* cB = (const char*)g.Bt + (size_t)cur.pn * tstep;
    S.a_ready(cur);
    if constexpr (SP2) {
        PG8_STAGE(PG8_SB(0, 0), cB, voffB); PG8_STAGE(PG8_SB(0, 1), cB + hstep, voffB); PG8_STAGE(PG8_SA(0, 0), cA, voffA); PG8_STAGE(PG8_SA(0, 1), cA + hstep, voffA);
        if (wr == 1) PG8_BAR;
        PG8_WAIT_V(2); PG8_BAR;
        PG8_STAGE(PG8_SB(1, 0), cB + kstep, voffB); PG8_STAGE(PG8_SA(1, 0), cA + kstep, voffA); PG8_STAGE(PG8_SB(1, 1), cB + hstep + kstep, voffB);
        PG8_WAIT_V(6); PG8_BAR;
    } else {
        PG8_STAGE(PG8_SB(0, 0), cB, voffB); PG8_STAGE(PG8_SA(0, 0), cA, voffA); PG8_STAGE(PG8_SB(0, 1), cB + hstep, voffB); PG8_STAGE(PG8_SA(0, 1), cA + hstep, voffA);
        if (wr == 1) PG8_BAR;
        PG8_WAIT_V(4); PG8_BAR;
        PG8_STAGE(PG8_SB(1, 0), cB + kstep, voffB); PG8_STAGE(PG8_SA(1, 0), cA + kstep, voffA); PG8_STAGE(PG8_SB(1, 1), cB + hstep + kstep, voffB);
        PG8_WAIT_V(6); PG8_BAR;
    }
    for (;;) {
        const bool has_next = S.next(ui + 1, nxt);
        const char* nA = has_next ? (const char*)g.A + (size_t)nxt.pm * tstep : cA; const char* nB = has_next ? (const char*)g.Bt + (size_t)nxt.pn * tstep : cB;
        for (int t = 0; t < nt; t += 2) {
            const bool last = (t == nt - 2);
            const char* a1 = cA + (size_t)(t + 1) * kstep;
            const char* a2 = last ? nA : cA + (size_t)(t + 2) * kstep; const char* b2 = last ? nB : cB + (size_t)(t + 2) * kstep;
            const char* a3 = a2 + kstep; const char* b3 = b2 + kstep;
            if (last && has_next) S.a_ready(nxt);
            if constexpr (SP2) {
            PG8_LDB(B0, 0, 0); PG8_LDB(B1, 0, 1); PG8_SCHED; PG8_LDA(At, 0, 0); PG8_STAGE(PG8_SA(1, 1), a1 + hstep, voffA);
            PG8_WAIT_V(8); PG8_WAIT_L(0); PG8_BAR; PG8_MMA(0, 0, At, B0); PG8_MMA(0, 1, At, B1); PG8_BAR; PG8_SCHED;
            PG8_LDA(At, 0, 1); PG8_STAGE(PG8_SB(0, 0), b2, voffB); PG8_STAGE(PG8_SB(0, 1), b2 + hstep, voffB); PG8_STAGE(PG8_SA(0, 0), a2, voffA);
            PG8_WAIT_V(8); PG8_WAIT_L(0); PG8_BAR; PG8_MMA(1, 0, At, B0); PG8_MMA(1, 1, At, B1); PG8_BAR; PG8_SCHED;
            PG8_LDB(B0, 1, 0); PG8_LDB(B1, 1, 1); PG8_SCHED; PG8_LDA(At, 1, 0); PG8_STAGE(PG8_SA(0, 1), a2 + hstep, voffA);
            PG8_WAIT_V(8); PG8_WAIT_L(0); PG8_BAR; PG8_MMA(0, 0, At, B0); PG8_MMA(0, 1, At, B1); PG8_BAR; PG8_SCHED;
            PG8_LDA(At, 1, 1); PG8_STAGE(PG8_SB(1, 0), b3, voffB); PG8_STAGE(PG8_SB(1, 1), b3 + hstep, voffB); PG8_STAGE(PG8_SA(1, 0), a3, voffA);
            PG8_WAIT_V(8); PG8_WAIT_L(0); PG8_BAR; PG8_MMA(1, 0, At, B0); PG8_MMA(1, 1, At, B1); PG8_BAR; PG8_SCHED;
            } else {
            PG8_LDB(B0, 0, 0); PG8_SCHED; PG8_LDA(At, 0, 0); PG8_STAGE(PG8_SA(1, 1), a1 + hstep, voffA);
            PG8_WAIT_L(8); PG8_BAR; PG8_WAIT_L(0); PG8_MMA(0, 0, At, B0); PG8_BAR; PG8_SCHED;
            PG8_LDB(B1, 0, 1); PG8_STAGE(PG8_SB(0, 0), b2, voffB);
            PG8_BAR; PG8_WAIT_L(0); PG8_MMA(0, 1, At, B1); PG8_BAR;
            PG8_LDA(At, 0, 1); PG8_STAGE(PG8_SA(0, 0), a2, voffA);
            PG8_BAR; PG8_WAIT_L(0); PG8_MMA(1, 0, At, B0); PG8_BAR; PG8_SCHED;
            PG8_STAGE(PG8_SB(0, 1), b2 + hstep, voffB);
            PG8_WAIT_V(6); PG8_BAR; PG8_MMA(1, 1, At, B1); PG8_BAR;
            PG8_LDB(B0, 1, 0); PG8_SCHED; PG8_LDA(At, 1, 0); PG8_STAGE(PG8_SA(0, 1), a2 + hstep, voffA);
            PG8_WAIT_L(8); PG8_BAR; PG8_WAIT_L(0); PG8_MMA(0, 0, At, B0); PG8_BAR; PG8_SCHED;
            PG8_LDB(B1, 1, 1); PG8_STAGE(PG8_SB(1, 0), b3, voffB);
            PG8_BAR; PG8_WAIT_L(0); PG8_MMA(0, 1, At, B1); PG8_BAR;
            PG8_LDA(At, 1, 1); PG8_STAGE(PG8_SA(1, 0), a3, voffA);
            PG8_BAR; PG8_WAIT_L(0); PG8_MMA(1, 0, At, B0); PG8_BAR; PG8_SCHED;
            PG8_STAGE(PG8_SB(1, 1), b3 + hstep, voffB);
            PG8_WAIT_V(6); PG8_BAR; PG8_MMA(1, 1, At, B1); PG8_BAR;
            }
        }
        if constexpr (ALIGN_EPI) { if (wr == 0) PG8_BAR; }
        if constexpr (!Epi::AFTER_DRAIN) { int t2_ = threadIdx.x; asm volatile("" : "+v"(t2_)); const int l2_ = t2_ & 63;
            E(acc, cur, wr, wc, l2_ & 15, l2_ >> 4); S.done(cur); }
        if (!has_next) break;
#pragma unroll
        for (int a = 0; a < 2; ++a)
#pragma unroll
            for (int b = 0; b < 2; ++b)
#pragma unroll
                for (int m = 0; m < 4; ++m)
#pragma unroll
                    for (int n = 0; n < 2; ++n) acc[a][b][m][n] = (f32x4){0.f, 0.f, 0.f, 0.f};
        cur = nxt; cA = nA; cB = nB; ++ui;
        if constexpr (ALIGN_EPI) { if (wr == 1) PG8_BAR; }
    }
    PG8_WAIT_V(0);
    if constexpr (!ALIGN_EPI) { if (wr == 0) PG8_BAR; }
    PG8_BAR;
    if constexpr (Epi::AFTER_DRAIN) { E.fused(acc, cur, wr, wc, fr, fq, lds, wid, lane); S.done(cur); }
#undef PG8_SA
#undef PG8_SB
#undef PG8_STAGE
#undef PG8_LDA
#undef PG8_LDB
#undef PG8_MMA
#undef PG8_WAIT_V
#undef PG8_WAIT_L
#undef PG8_BAR
#undef PG8_SCHED
}
}
#ifndef PG8_SP2
#define PG8_SP2 true
#endif
#ifndef PG8_ALIGN
#define PG8_ALIGN true
#endif
constexpr int NWAVES = 8;
#ifndef MK_N_LAUNCHES
#define MK_N_LAUNCHES 1
#endif
constexpr int N_PHASES = 8;
constexpr int N_LAUNCHES = MK_N_LAUNCHES;

constexpr int BATCH = 16, T = 2048, D = 1024, M = BATCH * T;
constexpr int DPLE = 256, NH = 4, DK = 64, DV = 128, KEY = 256, VAL = 512, RANK = 16, POOLW = 512, GC = 128;
constexpr int DIN = 2064, FF = 2816, NZ = 2048, NGU = 2 * FF;
constexpr int ZQ = 0, ZK = 256, ZV = 512, ZG = 1024, ZU = 1536;
constexpr float EPS = 1e-6f;

constexpr size_t MiB = 1u << 20;
constexpr size_t WS_CTL = 0, CTL_ZERO_BYTES = 1 * MiB;
constexpr size_t WS_WIN = 1 * MiB, WS_WOUT = 5 * MiB, WS_WGU = 7 * MiB, WS_WD = 18 * MiB, WS_WPG = 24 * MiB, WS_WPP = 26 * MiB;
constexpr int TFIX = 4;
constexpr size_t WS_ZF = 256 * 1024;
constexpr size_t WS_SSX = WS_ZF + (size_t)BATCH * TFIX * DIN * 4;
static_assert(WS_SSX + 256 <= 220000 * 4, "zf inside the zeroed control region, below the diagnostic words");
constexpr size_t WS_RSX = 27 * MiB, WS_GLR = 28 * MiB, WS_SSQ1 = 30 * MiB, WS_SSQ2 = 32 * MiB, WS_SSQ3 = 34 * MiB;
constexpr size_t WS_XB = 36 * MiB, WS_Z = 100 * MiB, WS_ACT = 36 * MiB  , WS_A2 = 228 * MiB, WS_H2B = 228 * MiB  ;
constexpr size_t WS_H1B = 292 * MiB, WS_PB = 356 * MiB, WS_GLRB = 372 * MiB  , WS_PP = 373 * MiB  , WS_END = 437 * MiB;
static_assert(WS_ACT + (size_t)M * FF * 2 <= WS_A2 && WS_Z + (size_t)M * NZ * 2 <= WS_A2 && WS_XB + (size_t)M * D * 2 <= WS_Z, "ws map");
static_assert(WS_WGU + (size_t)NGU * D * 2 <= WS_WD && WS_WD + (size_t)D * FF * 2 <= WS_WPG, "ws map (weights)");
constexpr int CW_TMO = 0, CW_CODE = 1;
constexpr int CW_BAR = 4096;

constexpr int RING_OFF = 0, RING_BYTES = 131072;
constexpr int LDSCTL_OFF = RING_BYTES, MISC_OFF = LDSCTL_OFF + 320;
constexpr int LDS_BYTES = 147456;
static_assert(MISC_OFF + 128 <= LDS_BYTES, "LDS map");

#define GAS __attribute__((address_space(1)))
#define LAS __attribute__((address_space(3)))
typedef unsigned short bf16;
typedef unsigned v4u __attribute__((ext_vector_type(4)));
typedef float f32x4 __attribute__((ext_vector_type(4)));
typedef short bf16x8 __attribute__((ext_vector_type(8)));
typedef GAS unsigned gu32;
typedef GAS unsigned long long gu64;
#define RLX_AGENT __ATOMIC_RELAXED, __HIP_MEMORY_SCOPE_AGENT
#define LDS_WAIT() asm volatile("s_waitcnt lgkmcnt(0)" ::: "memory")
#define VM_WAIT() asm volatile("s_waitcnt vmcnt(0)" ::: "memory")
__device__ __forceinline__ unsigned long long rt() { return __builtin_amdgcn_s_memrealtime(); }
__device__ __forceinline__ unsigned f2bf(float f) { unsigned u = __builtin_bit_cast(unsigned, f); return (u + 0x7fffu + ((u >> 16) & 1u)) >> 16; }
__device__ __forceinline__ unsigned pk2(float lo, float hi) { return f2bf(lo) | (f2bf(hi) << 16); }

#define XB_TMO      128
#define XB_XCNT(j)  (256  + 64 * (j))
#define XB_XSUB(j)  (1280 + 64 * (j))
#define XB_XGEN(j)  (2304 + 64 * (j))
#define XB_TOP      3328
#define XB_TOPGEN   3392
#define XCD_BAR_WORDS 3456
#define XB_SPIN_CAP (1u << 18)

__device__ __forceinline__ unsigned xb_ld(unsigned* p)              { return __hip_atomic_load(p, __ATOMIC_RELAXED, __HIP_MEMORY_SCOPE_AGENT); }
__device__ __forceinline__ unsigned xb_add(unsigned* p, unsigned v) { return __hip_atomic_fetch_add(p, v, __ATOMIC_RELAXED, __HIP_MEMORY_SCOPE_AGENT); }
__device__ __forceinline__ unsigned xb_xcc_id() { return (unsigned)__builtin_amdgcn_s_getreg((3 << 11) | 20) & 0xFu; }
#define XB_SPIN(cond, bar) do { unsigned _sp = 0; while (cond) { __builtin_amdgcn_s_sleep(1); \
    if ((++_sp & 255u) == 0u) { if (xb_ld(&(bar)[XB_TMO])) break; if (_sp > XB_SPIN_CAP) { atomicAdd(&(bar)[XB_TMO], 1u); break; } } } } while (0)

struct XcdBarrier {
    unsigned* bar; unsigned x;
    volatile LAS unsigned* st;
};

__device__ __forceinline__ XcdBarrier xcd_barrier_post(unsigned* bar, volatile LAS unsigned* st) {
    XcdBarrier b; b.bar = bar; b.x = xb_xcc_id(); b.st = st;
    if (threadIdx.x == 0) (void)xb_add(&bar[XB_XCNT(b.x)], 1u);
    return b;
}
__device__ __forceinline__ void xcd_barrier_complete(unsigned* bar, unsigned x, unsigned& nloc, unsigned& nx) {
    const unsigned G = gridDim.x * gridDim.y * gridDim.z;
    unsigned sum, cnt, mine, sp = 0u;
    for (;;) {
        sum = 0u; cnt = 0u; mine = 0u;
#pragma unroll
        for (unsigned j = 0; j < 16; ++j) { const unsigned c = xb_ld(&bar[XB_XCNT(j)]); sum += c; cnt += (c > 0u) ? 1u : 0u; mine = (j == x) ? c : mine; }
        if (sum == G) break;
        __builtin_amdgcn_s_sleep(1);
        if ((++sp & 255u) == 0u) { if (xb_ld(&bar[XB_TMO])) break; if (sp > XB_SPIN_CAP) { atomicAdd(&bar[XB_TMO], 1u); break; } }
    }
    nloc = mine > 0u ? mine : 1u; nx = cnt > 0u ? cnt : 1u;
}

__device__ __forceinline__ void xcd_barrier(const XcdBarrier& b) {
    asm volatile("s_waitcnt vmcnt(0)" ::: "memory");
    __syncthreads();
    if (threadIdx.x == 0) {
        unsigned* bar = b.bar;
        __builtin_amdgcn_s_waitcnt(0);
        unsigned nloc = b.st[0], nx = b.st[1];
        if (nloc == 0u) { xcd_barrier_complete(bar, b.x, nloc, nx); b.st[0] = nloc; b.st[1] = nx; }
        const unsigned old = xb_add(&bar[XB_XSUB(b.x)], 1u);
        const unsigned gen = old / nloc;
        if (old + 1u == (gen + 1u) * nloc) {
            __builtin_amdgcn_fence(__ATOMIC_RELEASE, "agent");
            asm volatile("s_waitcnt vmcnt(0)" ::: "memory");
            const unsigned og = xb_add(&bar[XB_TOP], 1u);
            const unsigned tg = og / nx;
            if (og + 1u == (tg + 1u) * nx) xb_add(&bar[XB_TOPGEN], 1u);
            else XB_SPIN(xb_ld(&bar[XB_TOPGEN]) == tg, bar);
            __builtin_amdgcn_fence(__ATOMIC_ACQUIRE, "agent");
            xb_add(&bar[XB_XGEN(b.x)], 1u);
            asm volatile("s_waitcnt vmcnt(0)" ::: "memory");
        } else {
            XB_SPIN(xb_ld(&bar[XB_XGEN(b.x)]) == gen, bar);
            __builtin_amdgcn_fence(__ATOMIC_ACQUIRE, "agent");
            asm volatile("s_waitcnt vmcnt(0)" ::: "memory");
        }
    }
    __syncthreads();
}

struct Frame {
    LAS unsigned char* lds;
    volatile LAS unsigned* MISC;
    gu32* ctl;
    int wave;
    int vcu, G;
    const float *x, *p, *ln_mix, *w_in, *w_gate_lr, *b_gate, *gla_norm, *w_pool, *pool_scale, *w_out, *ln_ffn, *w_gate, *w_up, *w_down, *ln_ple, *w_pg, *w_pp, *ln_final;
    float* out;
    bf16 *Win_t, *Wout_t, *Wgu_t, *Wd_t, *Wpg_t, *Wpp_t;
    float *rsx, *glr, *ssq1, *ssq2, *ssq3, *zf, *ssx;
    bf16* glrb;
    bf16 *XB, *Z, *ACT, *A2, *H2B, *H1B, *PP, *PB;
};
__device__ __forceinline__ int my_tid() { int t = threadIdx.x; asm volatile("" : "+v"(t)); return t; }
__device__ __forceinline__ float wave_sum(float v) {
#pragma unroll
    for (int o = 1; o < 64; o <<= 1) v += __shfl_xor(v, o);
    return v;
}
__device__ __forceinline__ float bf2f(bf16 v) { return __uint_as_float((unsigned)v << 16); }

struct SrcPlain { const float* w; int N; __device__ __forceinline__ float operator()(int k, int n) const { return w[(size_t)k * N + n]; } };
struct SrcGain { const float* w; int N; const float* g; int cshift; __device__ __forceinline__ float operator()(int k, int n) const { return w[(size_t)k * N + n + cshift] * g[k]; } };
template <class S>
__device__ __forceinline__ void p0_transpose_item(const S& src, int K, bf16* WT, int k0, int n0, LAS float* scr, int lane) {
#pragma unroll 16
    for (int i = 0; i < 32; ++i) { const int kk = 2 * i + (lane >> 5); scr[kk * 33 + (lane & 31)] = src(k0 + kk, n0 + (lane & 31)); }
    LDS_WAIT(); asm volatile("" ::: "memory");
    const int c = lane & 7;
#pragma unroll
    for (int j = 0; j < 4; ++j) { const int n = (lane >> 3) + 8 * j; const LAS float* s = scr + (8 * c) * 33 + n;
        v4u o; o.x = pk2(s[0 * 33], s[1 * 33]); o.y = pk2(s[2 * 33], s[3 * 33]); o.z = pk2(s[4 * 33], s[5 * 33]); o.w = pk2(s[6 * 33], s[7 * 33]);
        *(GAS v4u*)(WT + (size_t)(n0 + n) * K + k0 + 8 * c) = o; }
    LDS_WAIT(); asm volatile("" ::: "memory");
}
typedef float f32x16p __attribute__((ext_vector_type(16)));
__device__ __forceinline__ f32x16p f32_tile(const float* arow, const float* ascale, const float* bcol, int ldb, int K, int lane, float& ss) {
    const int h4 = 4 * (lane >> 5);
    f32x16p acc;
#pragma unroll
    for (int e = 0; e < 16; ++e) acc[e] = 0.f;
    float s2 = 0.f;
#pragma unroll 4
    for (int k0 = 0; k0 < K; k0 += 8) {
        f32x4 av = *(const f32x4*)(arow + k0 + h4);
        s2 += (av[0] * av[0] + av[1] * av[1]) + (av[2] * av[2] + av[3] * av[3]);
        if (ascale) av = av * *(const f32x4*)(ascale + k0 + h4);
        float bv[4];
#pragma unroll
        for (int e = 0; e < 4; ++e) bv[e] = bcol[(size_t)(k0 + h4 + e) * ldb];
#pragma unroll
        for (int e = 0; e < 4; ++e) acc = __builtin_amdgcn_mfma_f32_32x32x2f32(av[e], bv[e], acc, 0, 0, 0);
    }
    ss = s2; return acc;
}
__device__ __forceinline__ void p0_wcomb_item(Frame& F, int item) {
    const int lane = my_tid() & 63, nb = item & 31, ct = (item >> 5) & 3, g = item >> 7, r = lane & 31, hh = lane >> 5;
    const float* arow = F.w_pool + (size_t)(g * GC + 32 * ct + r) * GC;
    const int n = nb * 32 + r; float ss;
    const f32x16p acc = f32_tile(arow, F.pool_scale + g * GC, F.w_out + (size_t)(VAL + g * GC) * D + n, D, GC, lane, ss);
    bf16* dst = F.Wout_t + (size_t)n * D + VAL + g * GC + 32 * ct + 4 * hh;
#pragma unroll
    for (int q4 = 0; q4 < 4; ++q4) { typedef unsigned u32x2v __attribute__((ext_vector_type(2))); u32x2v o; o.x = pk2(acc[4 * q4], acc[4 * q4 + 1]); o.y = pk2(acc[4 * q4 + 2], acc[4 * q4 + 3]); *(GAS u32x2v*)(dst + 8 * q4) = o; }
}
constexpr int ZF_NT = 49, ZF_KC = 16;
__device__ __forceinline__ void p0_zf_item(Frame& F, int item) {
    const int lane = my_tid() & 63, kc = item % ZF_KC, it2 = item / ZF_KC, mt = it2 / ZF_NT, nt = it2 % ZF_NT, r = lane & 31, hh = lane >> 5;
    const int ri = 32 * mt + r, b = ri / TFIX, t = ri % TFIX;
    const int c = 32 * nt + r; const bool ok = c < 1552; const int cl = ok ? c : 1551;
    float ss;
    const f32x16p acc = f32_tile(F.x + ((size_t)b * T + t) * D + 64 * kc, F.ln_mix + 64 * kc, F.w_in + (size_t)(64 * kc) * DIN + cl, DIN, 64, lane, ss);
    if (nt == 0) atomicAdd(F.ssx + ri, ss);
    if (ok) {
#pragma unroll
        for (int e = 0; e < 16; ++e) { const int i = (e & 3) + 8 * (e >> 2) + 4 * hh; atomicAdd(F.zf + (size_t)(32 * mt + i) * DIN + c, acc[e]); }
    }
}
constexpr int GLR_PITCH = 1032;
constexpr int P0_SCR_BYTES = 8704, P0_BT_OFF = NWAVES * P0_SCR_BYTES;
static_assert(P0_BT_OFF + RANK * GLR_PITCH * 2 <= RING_BYTES, "P0 LDS map");
__device__ __forceinline__ void p0_x_task(Frame& F, int task) {
    const int lane = my_tid() & 63; const int m0 = task * 16, row = lane & 15, kq = lane >> 4;
    const float* xr = F.x + (size_t)(m0 + row) * D + 8 * kq;
    bf16* xbr = F.XB + (size_t)(m0 + row) * D + 8 * kq;
    const LAS unsigned char* bt = F.lds + P0_BT_OFF + (row * GLR_PITCH + 8 * kq) * 2;
    pg8::f32x4 acc = {0.f, 0.f, 0.f, 0.f}; float ssq = 0.f;
#pragma unroll 8
    for (int kc = 0; kc < 32; ++kc) {
        const f32x4 a0 = *(const f32x4*)(xr + 32 * kc), a1 = *(const f32x4*)(xr + 32 * kc + 4);
        ssq += ((a0[0] * a0[0] + a0[1] * a0[1]) + (a0[2] * a0[2] + a0[3] * a0[3])) + ((a1[0] * a1[0] + a1[1] * a1[1]) + (a1[2] * a1[2] + a1[3] * a1[3]));
        v4u w; w.x = pk2(a0[0], a0[1]); w.y = pk2(a0[2], a0[3]); w.z = pk2(a1[0], a1[1]); w.w = pk2(a1[2], a1[3]);
        *(GAS v4u*)(xbr + 32 * kc) = w;
        const bf16x8 af = __builtin_bit_cast(bf16x8, w);
        const bf16x8 bfv = *(const LAS bf16x8*)(bt + 64 * kc);
        acc = __builtin_amdgcn_mfma_f32_16x16x32_bf16(af, bfv, acc, 0, 0, 0);
    }
    ssq += __shfl_xor(ssq, 16); ssq += __shfl_xor(ssq, 32);
    const float rstd = 1.0f / sqrtf(ssq * (1.0f / D) + EPS);
    if (lane < 16) F.rsx[m0 + lane] = rstd;
#pragma unroll
    for (int r = 0; r < 4; ++r) { const float rt = __shfl(rstd, 4 * kq + r); const float gv = acc[r] * rt; F.glr[(size_t)(m0 + 4 * kq + r) * RANK + row] = gv; F.glrb[(size_t)(m0 + 4 * kq + r) * RANK + row] = (bf16)f2bf(gv); }
}
__device__ __forceinline__ void p0_prologue(Frame& F) {
    const int tid = my_tid(), lane = tid & 63;
    for (int idx = tid; idx < RANK * D; idx += NWAVES * 64) { const int k = idx >> 4, r = idx & 15;
        *(LAS bf16*)(F.lds + P0_BT_OFF + (r * GLR_PITCH + k) * 2) = (bf16)f2bf(F.w_in[(size_t)k * DIN + 1536 + r] * F.ln_mix[k]); }
    __syncthreads();
    LAS float* scr = (LAS float*)(F.lds + RING_OFF + F.wave * P0_SCR_BYTES);
    const int gw = F.vcu * NWAVES + F.wave, NGW = F.G * NWAVES;
    for (int it = gw; it < 2 * ZF_NT * ZF_KC + 512; it += NGW) { if (it < 2 * ZF_NT * ZF_KC) p0_zf_item(F, it); else p0_wcomb_item(F, it - 2 * ZF_NT * ZF_KC); }
    constexpr int I_IN = (D / 64) * (NZ / 32), I_OUT = (VAL / 64) * (D / 32), I_GU = (D / 64) * (NGU / 32), I_D = (FF / 64) * (D / 32), I_PG = (D / 64) * (D / 32), I_PP = (DPLE / 64) * (D / 32);
    constexpr int NITEMS = I_IN + I_OUT + I_GU + I_D + I_PG + I_PP;
    for (int it = gw; it < NITEMS; it += NGW) {
        int r = it;
        if (r < I_IN) { const int nblk = NZ / 32; const int n0 = 32 * (r % nblk); p0_transpose_item(SrcGain{F.w_in, DIN, F.ln_mix, n0 < 1536 ? 0 : 16}, D, F.Win_t, 64 * (r / nblk), n0, scr, lane); continue; } r -= I_IN;
        if (r < I_OUT) { const int nblk = D / 32; p0_transpose_item(SrcPlain{F.w_out, D}, D, F.Wout_t, 64 * (r / nblk), 32 * (r % nblk), scr, lane); continue; } r -= I_OUT;
        if (r < I_GU) { const int nblk = NGU / 32; const int n0 = 32 * (r % nblk), j = n0 >> 8, rr = n0 & 255;
            if (rr < 128) p0_transpose_item(SrcGain{F.w_gate, FF, F.ln_ffn, -128 * j}, D, F.Wgu_t, 64 * (r / nblk), n0, scr, lane);
            else p0_transpose_item(SrcGain{F.w_up, FF, F.ln_ffn, -128 * j - 128}, D, F.Wgu_t, 64 * (r / nblk), n0, scr, lane);
            continue; } r -= I_GU;
        if (r < I_D) { const int nblk = D / 32; p0_transpose_item(SrcPlain{F.w_down, D}, FF, F.Wd_t, 64 * (r / nblk), 32 * (r % nblk), scr, lane); continue; } r -= I_D;
        if (r < I_PG) { const int nblk = D / 32; p0_transpose_item(SrcGain{F.w_pg, D, F.ln_ple, 0}, D, F.Wpg_t, 64 * (r / nblk), 32 * (r % nblk), scr, lane); continue; } r -= I_PG;
        { const int nblk = D / 32; p0_transpose_item(SrcPlain{F.w_pp, D}, DPLE, F.Wpp_t, 64 * (r / nblk), 32 * (r % nblk), scr, lane); }
    }
    for (int t = gw; t < M / 16; t += NGW) p0_x_task(F, t);
    { const size_t NP = (size_t)M * DPLE / 8, stride = (size_t)F.G * NWAVES * 64;
      for (size_t i0 = (size_t)(F.vcu * NWAVES * 64 + tid); i0 < NP; i0 += 4 * stride) {
          f32x4 a0[4], a1[4];
#pragma unroll
          for (int u = 0; u < 4; ++u) { const size_t i = i0 + u * stride; if (i < NP) { a0[u] = *(const f32x4*)(F.p + 8 * i); a1[u] = *(const f32x4*)(F.p + 8 * i + 4); } }
#pragma unroll
          for (int u = 0; u < 4; ++u) { const size_t i = i0 + u * stride; if (i < NP) { v4u w; w.x = pk2(a0[u][0], a0[u][1]); w.y = pk2(a0[u][2], a0[u][3]); w.z = pk2(a1[u][0], a1[u][1]); w.w = pk2(a1[u][2], a1[u][3]); *(GAS v4u*)(F.PB + 8 * i) = w; } }
      } }
}

#ifndef DIAG_MODE
#define DIAG_MODE 0
#endif
constexpr int CW_DIAG = 220000;
template <bool CMP>
__device__ __forceinline__ void p2_gla_simple_t(Frame& F, int bh) {
    const int b = bh >> 2, h = bh & 3, tid = my_tid(), lane = tid & 63;
    LAS float* sq = (LAS float*)(F.lds); LAS float* sk = sq + 64; LAS float* sa = sk + 64; LAS float* red = sa + 64;
    float S[DK]; float wgc[RANK]; float bg = 0.f, gn = 0.f;
#pragma unroll
    for (int d = 0; d < DK; ++d) S[d] = 0.f;
#pragma unroll
    for (int r = 0; r < RANK; ++r) wgc[r] = (tid < 64) ? F.w_gate_lr[r * KEY + h * DK + tid] : 0.f;
    if (tid < 64) bg = F.b_gate[h * DK + tid];
    if (tid < 128) gn = F.gla_norm[tid];
    for (int t = 0; t < T; ++t) {
        const size_t m = (size_t)b * T + t;
        if (tid < 64) {
            float pre = bg;
#pragma unroll
            for (int r = 0; r < RANK; ++r) pre = fmaf(F.glr[m * RANK + r], wgc[r], pre);
            const float ls = fminf(pre, 0.f) - log1pf(expf(-fabsf(pre)));
            sa[tid] = expf(ls * (1.0f / 16.0f));
            sq[tid] = bf2f(F.Z[m * NZ + ZQ + h * DK + tid]) * 0.125f;
            sk[tid] = bf2f(F.Z[m * NZ + ZK + h * DK + tid]);
        }
        __syncthreads();
        float o = 0.f;
        if (tid < 128) {
            const float vv = bf2f(F.Z[m * NZ + ZV + h * DV + tid]);
#pragma unroll
            for (int d = 0; d < DK; ++d) { S[d] = fmaf(sa[d], S[d], sk[d] * vv); o = fmaf(sq[d], S[d], o); }
            const float s2 = wave_sum(o * o);
            if (lane == 0) red[F.wave] = s2;
        }
        __syncthreads();
        if (tid < 128) {
            const float rstd = 1.0f / sqrtf((red[0] + red[1]) * (1.0f / DV) + EPS);
            const float g = bf2f(F.Z[m * NZ + ZG + h * DV + tid]);
            const float val = o * rstd * gn * (g / (1.0f + expf(-g)));
            if (!CMP) F.A2[m * D + h * DV + tid] = (bf16)f2bf(val);
            else if (t >= TFIX) { const float df = fabsf(val - bf2f(F.A2[m * D + h * DV + tid]));
                const int cat = (DIAG_MODE == 1) ? (t & 63) : (DIAG_MODE == 2) ? (t >> 6) : (DIAG_MODE == 3) ? (tid >> 1) : (DIAG_MODE == 4) ? bh : 0;
                atomicMax((unsigned*)(F.ctl + CW_DIAG) + cat, __float_as_uint(df)); }
        }
    }
}
__device__ __forceinline__ void p2_gla_simple(Frame& F, int bh) { p2_gla_simple_t<false>(F, bh); }
__device__ __forceinline__ void p2_gla_fix(Frame& F, int bh) {
    const int b = bh >> 2, h = bh & 3, tid = my_tid(), lane = tid & 63;
    LAS float* sq = (LAS float*)(F.lds); LAS float* sk = sq + 64; LAS float* sa = sk + 64; LAS float* red = sa + 64;
    float S[DK]; float wgc[RANK]; float bg = 0.f, gn = 0.f;
#pragma unroll
    for (int d = 0; d < DK; ++d) S[d] = 0.f;
#pragma unroll
    for (int r = 0; r < RANK; ++r) wgc[r] = (tid < 64) ? F.w_gate_lr[r * KEY + h * DK + tid] : 0.f;
    if (tid < 64) bg = F.b_gate[h * DK + tid];
    if (tid < 128) gn = F.gla_norm[tid];
    __syncthreads();
    for (int t = 0; t < TFIX; ++t) {
        const float* zr = F.zf + (size_t)(b * TFIX + t) * DIN; const size_t m = (size_t)b * T + t;
        const float rz = 1.0f / sqrtf(F.ssx[b * TFIX + t] * (1.0f / D) + EPS);
        if (tid < 64) {
            float pre = bg;
#pragma unroll
            for (int r = 0; r < RANK; ++r) pre = fmaf(zr[1536 + r] * rz, wgc[r], pre);
            const float ls = fminf(pre, 0.f) - log1pf(expf(-fabsf(pre)));
            sa[tid] = expf(ls * (1.0f / 16.0f));
            sq[tid] = zr[h * DK + tid] * rz * 0.125f;
            sk[tid] = zr[256 + h * DK + tid] * rz;
        }
        __syncthreads();
        float o = 0.f;
        if (tid < 128) {
            const float vv = zr[512 + h * DV + tid] * rz;
#pragma unroll
            for (int d = 0; d < DK; ++d) { S[d] = fmaf(sa[d], S[d], sk[d] * vv); o = fmaf(sq[d], S[d], o); }
            const float s2 = wave_sum(o * o);
            if (lane == 0) red[F.wave] = s2;
        }
        __syncthreads();
        if (tid < 128) {
            const float rstd = 1.0f / sqrtf((red[0] + red[1]) * (1.0f / DV) + EPS);
            const float g = zr[1024 + h * DV + tid] * rz;
            const float val = o * rstd * gn * (g / (1.0f + expf(-g)));
            F.A2[m * D + h * DV + tid] = (bf16)f2bf(val);
        }
    }
}
typedef float f32x16 __attribute__((ext_vector_type(16)));
typedef short v4i16_t __attribute__((ext_vector_type(4)));
typedef float f32x2_t __attribute__((ext_vector_type(2))); typedef __bf16 bf16x2_t __attribute__((ext_vector_type(2)));
__device__ __forceinline__ unsigned cvtpk_c(float lo, float hi) { f32x2_t v = {lo, hi}; bf16x2_t bb = __builtin_convertvector(v, bf16x2_t); return __builtin_bit_cast(unsigned, bb); }
typedef unsigned u32x2 __attribute__((ext_vector_type(2)));
constexpr int G_QE = 0, G_KE = 9216, G_KD = 18432, G_VB = 30720, G_OT = 71680, G_EL = 105472, G_END = 105728;
constexpr int QK_P = 144, KD_P = 192, V_P = 320, OT_P = 528, VB_BYTES = 64 * V_P;
static_assert(G_KE == G_QE + 64 * QK_P && G_KD == G_KE + 64 * QK_P && G_VB == G_KD + 64 * KD_P && G_OT == G_VB + 2 * VB_BYTES && G_EL == G_OT + 64 * OT_P && G_END <= RING_BYTES, "GLA LDS map");
#define GLA_BAR() do { asm volatile("s_waitcnt lgkmcnt(0)" ::: "memory"); __builtin_amdgcn_s_barrier(); asm volatile("" ::: "memory"); } while (0)
__device__ __forceinline__ float dpp_shr(float v, int n) {
    const int iv = __builtin_bit_cast(int, v); int r;
    switch (n) { case 1: r = __builtin_amdgcn_update_dpp(0, iv, 0x111, 0xf, 0xf, true); break; case 2: r = __builtin_amdgcn_update_dpp(0, iv, 0x112, 0xf, 0xf, true); break;
                 case 4: r = __builtin_amdgcn_update_dpp(0, iv, 0x114, 0xf, 0xf, true); break; default: r = __builtin_amdgcn_update_dpp(0, iv, 0x118, 0xf, 0xf, true); break; }
    return __builtin_bit_cast(float, r);
}
__device__ __forceinline__ bf16x8 tr8(const LAS unsigned char* p0, const LAS unsigned char* p1) {
    const v4i16_t a = __builtin_amdgcn_ds_read_tr16_b64_v4i16((LAS v4i16_t*)p0), b = __builtin_amdgcn_ds_read_tr16_b64_v4i16((LAS v4i16_t*)p1);
    bf16x8 r; r[0] = a[0]; r[1] = a[1]; r[2] = a[2]; r[3] = a[3]; r[4] = b[0]; r[5] = b[1]; r[6] = b[2]; r[7] = b[3]; return r;
}
__device__ __forceinline__ bf16x8 cvt8(const f32x16& x, int s) {
    v4u w; w.x = cvtpk_c(x[8 * s + 0], x[8 * s + 1]); w.y = cvtpk_c(x[8 * s + 2], x[8 * s + 3]); w.z = cvtpk_c(x[8 * s + 4], x[8 * s + 5]); w.w = cvtpk_c(x[8 * s + 6], x[8 * s + 7]);
    return __builtin_bit_cast(bf16x8, w);
}
#define MFMA32(a, b, c) __builtin_amdgcn_mfma_f32_32x32x16_bf16((a), (b), (c), 0, 0, 0)
__device__ __forceinline__ void p2_gla_chunked(Frame& F, int bh) {
    const int b = bh >> 2, h = bh & 3, tid = my_tid(), lane = tid & 63, wave = F.wave;
    const LAS unsigned char* L = F.lds;
    constexpr int NCH = T / 64;
    const size_t mb = (size_t)b * T;
    if (wave < 4) {
        const int w = wave, g4 = lane >> 4, tl = lane & 15, r = lane & 31, hh = lane >> 5;
        bf16x8 wgA;
#pragma unroll
        for (int j = 0; j < 8; ++j) wgA[j] = (g4 < 2) ? (short)f2bf(F.w_gate_lr[(8 * g4 + j) * KEY + h * DK + 16 * w + tl]) : (short)0;
        float bg4[4];
#pragma unroll
        for (int e = 0; e < 4; ++e) bg4[e] = F.b_gate[h * DK + 16 * w + 4 * g4 + e];
        const int pos_nat = 16 * w + 4 * g4, pos_perm = 16 * w + 8 * (g4 & 1) + 4 * (g4 >> 1);
        u32x2 qr[4], kr[4]; bf16x8 gB[4];
        auto prefetch = [&](int n) {
#pragma unroll
            for (int tile = 0; tile < 4; ++tile) { const size_t m = mb + 64 * n + 16 * tile + tl;
                qr[tile] = *(const GAS u32x2*)(F.Z + m * NZ + ZQ + h * DK + pos_nat);
                kr[tile] = *(const GAS u32x2*)(F.Z + m * NZ + ZK + h * DK + pos_nat);
                if (g4 < 2) gB[tile] = *(const GAS bf16x8*)(F.glrb + m * RANK + 8 * g4); else gB[tile] = (bf16x8){0, 0, 0, 0, 0, 0, 0, 0}; }
        };
        prefetch(0);
        f32x16 S0, S1;
#pragma unroll
        for (int e = 0; e < 16; ++e) { S0[e] = 0.f; S1[e] = 0.f; }
        const int qe_frag = (r * QK_P) + 16 * hh;
        const int trq = (tl >> 2), trp = (tl & 3), gsel = g4 & 1;
        const int v_tr = (4 * hh + trq) * V_P + (32 * w + 16 * gsel + 4 * trp) * 2;
        const int kd_tr = (4 * hh + trq) * KD_P + (16 * gsel + 4 * trp) * 2;
        for (int n = 0; n < NCH; ++n) {
            float bcar[4] = {0.f, 0.f, 0.f, 0.f}; float bv[4][4];
#pragma unroll
            for (int tile = 0; tile < 4; ++tile) {
                const f32x4 pre = __builtin_amdgcn_mfma_f32_16x16x32_bf16(wgA, gB[tile], (f32x4){0.f, 0.f, 0.f, 0.f}, 0, 0, 0);
#pragma unroll
                for (int e = 0; e < 4; ++e) {
                    const float x = pre[e] + bg4[e];
                    const float ex = __builtin_amdgcn_exp2f(-1.44269504f * fabsf(x));
                    float s = (fminf(x, 0.f) - 0.693147181f * __builtin_amdgcn_logf(1.0f + ex)) * (1.0f / 16.0f);
                    s += dpp_shr(s, 1); s += dpp_shr(s, 2); s += dpp_shr(s, 4); s += dpp_shr(s, 8);
                    s += bcar[e]; bv[tile][e] = s;
                    bcar[e] = __shfl(s, (lane & 48) | 15);
                }
            }
            float eL[4];
#pragma unroll
            for (int e = 0; e < 4; ++e) eL[e] = __builtin_amdgcn_exp2f(1.44269504f * bcar[e]);
            if (tl == 0) *(LAS f32x4*)(L + G_EL + (16 * w + 4 * g4) * 4) = (f32x4){eL[0], eL[1], eL[2], eL[3]};
#pragma unroll
            for (int tile = 0; tile < 4; ++tile) {
                const int t = 16 * tile + tl;
                const float qf[4] = {pg8::bf_lo(qr[tile].x), pg8::bf_hi(qr[tile].x), pg8::bf_lo(qr[tile].y), pg8::bf_hi(qr[tile].y)};
                const float kf[4] = {pg8::bf_lo(kr[tile].x), pg8::bf_hi(kr[tile].x), pg8::bf_lo(kr[tile].y), pg8::bf_hi(kr[tile].y)};
                float qe[4], ke[4], kd[4];
#pragma unroll
                for (int e = 0; e < 4; ++e) { const float e1 = __builtin_amdgcn_exp2f(1.44269504f * bv[tile][e]), e2 = __builtin_amdgcn_rcpf(e1);
                    qe[e] = qf[e] * 0.125f * e1; ke[e] = kf[e] * e2; kd[e] = ke[e] * eL[e]; }
                u32x2 o;
                o.x = cvtpk_c(qe[0], qe[1]); o.y = cvtpk_c(qe[2], qe[3]); *(LAS u32x2*)(L + G_QE + t * QK_P + pos_perm * 2) = o;
                o.x = cvtpk_c(ke[0], ke[1]); o.y = cvtpk_c(ke[2], ke[3]); *(LAS u32x2*)(L + G_KE + t * QK_P + pos_perm * 2) = o;
                o.x = cvtpk_c(kd[0], kd[1]); o.y = cvtpk_c(kd[2], kd[3]); *(LAS u32x2*)(L + G_KD + t * KD_P + pos_nat * 2) = o;
            }
            GLA_BAR();
            if (n + 1 < NCH) prefetch(n + 1);
            const LAS unsigned char* vb = L + G_VB + (n & 1) * VB_BYTES;
            bf16x8 qeF[2][4];
#pragma unroll
            for (int it = 0; it < 2; ++it)
#pragma unroll
                for (int s = 0; s < 4; ++s) qeF[it][s] = *(const LAS bf16x8*)(L + G_QE + qe_frag + 32 * it * QK_P + 32 * s);
            f32x16 O0, O1;
#pragma unroll
            for (int e = 0; e < 16; ++e) { O0[e] = 0.f; O1[e] = 0.f; }
            { const bf16x8 sb00 = cvt8(S0, 0), sb01 = cvt8(S0, 1), sb10 = cvt8(S1, 0), sb11 = cvt8(S1, 1);
              O0 = MFMA32(qeF[0][0], sb00, O0); O1 = MFMA32(qeF[1][0], sb00, O1);
              O0 = MFMA32(qeF[0][1], sb01, O0); O1 = MFMA32(qeF[1][1], sb01, O1);
              O0 = MFMA32(qeF[0][2], sb10, O0); O1 = MFMA32(qeF[1][2], sb10, O1);
              O0 = MFMA32(qeF[0][3], sb11, O0); O1 = MFMA32(qeF[1][3], sb11, O1); }
            bf16x8 vF[2][2];
#pragma unroll
            for (int jt = 0; jt < 2; ++jt)
#pragma unroll
                for (int s = 0; s < 2; ++s) { const LAS unsigned char* p = vb + v_tr + (32 * jt + 16 * s) * V_P; vF[jt][s] = tr8(p, p + 8 * V_P); }
            { bf16x8 keF[4];
#pragma unroll
              for (int s = 0; s < 4; ++s) keF[s] = *(const LAS bf16x8*)(L + G_KE + qe_frag + 32 * s);
              f32x16 X;
#pragma unroll
              for (int e = 0; e < 16; ++e) X[e] = 0.f;
#pragma unroll
              for (int s = 0; s < 4; ++s) X = MFMA32(keF[s], qeF[0][s], X);
#pragma unroll
              for (int e = 0; e < 16; ++e) { const int jl = (e & 3) + 8 * (e >> 2) + 4 * hh; X[e] = (jl <= r) ? X[e] : 0.f; }
              O0 = MFMA32(cvt8(X, 0), vF[0][0], O0); O0 = MFMA32(cvt8(X, 1), vF[0][1], O0);
#pragma unroll
              for (int e = 0; e < 16; ++e) X[e] = 0.f;
#pragma unroll
              for (int s = 0; s < 4; ++s) X = MFMA32(keF[s], qeF[1][s], X);
              O1 = MFMA32(cvt8(X, 0), vF[0][0], O1); O1 = MFMA32(cvt8(X, 1), vF[0][1], O1);
#pragma unroll
              for (int s = 0; s < 4; ++s) keF[s] = *(const LAS bf16x8*)(L + G_KE + qe_frag + 32 * QK_P + 32 * s);
#pragma unroll
              for (int e = 0; e < 16; ++e) X[e] = 0.f;
#pragma unroll
              for (int s = 0; s < 4; ++s) X = MFMA32(keF[s], qeF[1][s], X);
#pragma unroll
              for (int e = 0; e < 16; ++e) { const int jl = (e & 3) + 8 * (e >> 2) + 4 * hh; X[e] = (jl <= r) ? X[e] : 0.f; }
              O1 = MFMA32(cvt8(X, 0), vF[1][0], O1); O1 = MFMA32(cvt8(X, 1), vF[1][1], O1); }
            {
#pragma unroll
              for (int q4 = 0; q4 < 4; ++q4) { const f32x4 e0 = *(const LAS f32x4*)(L + G_EL + (8 * q4 + 4 * hh) * 4), e1 = *(const LAS f32x4*)(L + G_EL + (32 + 8 * q4 + 4 * hh) * 4);
#pragma unroll
                  for (int e = 0; e < 4; ++e) { S0[4 * q4 + e] *= e0[e]; S1[4 * q4 + e] *= e1[e]; } }
#pragma unroll
              for (int jt = 0; jt < 2; ++jt)
#pragma unroll
                  for (int s = 0; s < 2; ++s) { const LAS unsigned char* p = L + G_KD + kd_tr + (32 * jt + 16 * s) * KD_P;
                      S0 = MFMA32(tr8(p, p + 8 * KD_P), vF[jt][s], S0); S1 = MFMA32(tr8(p + 64, p + 64 + 8 * KD_P), vF[jt][s], S1); } }
#pragma unroll
            for (int e = 0; e < 16; ++e) { const int i = (e & 3) + 8 * (e >> 2) + 4 * hh;
                *(LAS float*)(L + G_OT + i * OT_P + (32 * w + r) * 4) = O0[e]; *(LAS float*)(L + G_OT + (32 + i) * OT_P + (32 * w + r) * 4) = O1[e]; }
            GLA_BAR();
        }
    } else {
        const int hw = wave - 4, ro = 16 * hw + (lane >> 2), qd = lane & 3;
        float gn[32];
#pragma unroll
        for (int i = 0; i < 32; ++i) gn[i] = F.gla_norm[32 * qd + i];
        const int vrow = 4 * hw + (lane >> 4), vpc = lane & 15;
        v4u vst[4];
        auto vload = [&](int n) {
#pragma unroll
            for (int ps = 0; ps < 4; ++ps) vst[ps] = *(const GAS v4u*)(F.Z + (mb + 64 * n + 16 * ps + vrow) * NZ + ZV + h * DV + 8 * vpc);
        };
        auto vwrite = [&](int n) {
#pragma unroll
            for (int ps = 0; ps < 4; ++ps) *(LAS v4u*)(L + G_VB + (n & 1) * VB_BYTES + (16 * ps + vrow) * V_P + 16 * vpc) = vst[ps];
        };
        auto output = [&](int c) {
            const size_t m = mb + 64 * c + ro;
            v4u gw4[4];
#pragma unroll
            for (int i = 0; i < 4; ++i) gw4[i] = *(const GAS v4u*)(F.Z + m * NZ + ZG + h * DV + 32 * qd + 8 * i);
            f32x4 o[8]; float ss = 0.f;
#pragma unroll
            for (int i = 0; i < 8; ++i) { o[i] = *(const LAS f32x4*)(L + G_OT + ro * OT_P + (32 * qd + 4 * i) * 4); ss += (o[i][0] * o[i][0] + o[i][1] * o[i][1]) + (o[i][2] * o[i][2] + o[i][3] * o[i][3]); }
            ss += __shfl_xor(ss, 1); ss += __shfl_xor(ss, 2);
            const float rstd = 1.0f / sqrtf(ss * (1.0f / DV) + EPS);
            v4u ow[4];
#pragma unroll
            for (int i = 0; i < 4; ++i) { const unsigned gwv[4] = {gw4[i].x, gw4[i].y, gw4[i].z, gw4[i].w}; unsigned pk[4];
#pragma unroll
                for (int e = 0; e < 4; ++e) { const float g0 = pg8::bf_lo(gwv[e]), g1 = pg8::bf_hi(gwv[e]); const int c0 = 8 * i + 2 * e;
                    const float v0 = o[c0 >> 2][c0 & 3] * rstd * gn[c0] * (g0 * pg8::sigmoid_f(g0)), v1 = o[(c0 + 1) >> 2][(c0 + 1) & 3] * rstd * gn[c0 + 1] * (g1 * pg8::sigmoid_f(g1));
                    pk[e] = cvtpk_c(v0, v1); }
                ow[i] = (v4u){pk[0], pk[1], pk[2], pk[3]}; }
            if (!(c == 0 && ro < TFIX)) {
#pragma unroll
                for (int i = 0; i < 4; ++i) *(GAS v4u*)(F.A2 + m * D + h * DV + 32 * qd + 8 * i) = ow[i]; }
        };
        vload(0); vwrite(0);
        for (int n = 0; n < NCH; ++n) {
            if (n + 1 < NCH) vload(n + 1);
            if (n > 0) output(n - 1);
            GLA_BAR();
            if (n + 1 < NCH) vwrite(n + 1);
            GLA_BAR();
        }
        output(NCH - 1);
    }
    __syncthreads();
}
__device__ __forceinline__ void p2_pool_simple(Frame& F, int start, int stride) {
    for (int i = start; i < M * (POOLW / 8); i += stride) {
        const int m = i >> 6, c8 = i & 63, c = c8 * 8, t = m & (T - 1), g = c >> 7;
        const int w = 2 << g, cnt = (t + 1 < w) ? (t + 1) : w;
        float s[8];
#pragma unroll
        for (int e = 0; e < 8; ++e) s[e] = 0.f;
        float u0[8];
        for (int j = 0; j < cnt; ++j) {
            const v4u pw = *(const GAS v4u*)(F.Z + (size_t)(m - j) * NZ + ZU + c);
            const float v[8] = {pg8::bf_lo(pw.x), pg8::bf_hi(pw.x), pg8::bf_lo(pw.y), pg8::bf_hi(pw.y), pg8::bf_lo(pw.z), pg8::bf_hi(pw.z), pg8::bf_lo(pw.w), pg8::bf_hi(pw.w)};
#pragma unroll
            for (int e = 0; e < 8; ++e) { s[e] += v[e]; if (j == 0) u0[e] = v[e]; }
        }
        const float inv = 1.0f / (float)cnt;
        v4u o; o.x = pk2(s[0] * inv - u0[0], s[1] * inv - u0[1]); o.y = pk2(s[2] * inv - u0[2], s[3] * inv - u0[3]);
        o.z = pk2(s[4] * inv - u0[4], s[5] * inv - u0[5]); o.w = pk2(s[6] * inv - u0[6], s[7] * inv - u0[7]);
        *(GAS v4u*)(F.A2 + (size_t)m * D + VAL + c) = o;
    }
}
__device__ __forceinline__ void p7_final(Frame& F) {
    const int gw = F.vcu * NWAVES + F.wave, NGW = F.G * NWAVES, lane = my_tid() & 63;
    f32x4 gv[4];
#pragma unroll
    for (int j = 0; j < 4; ++j) gv[j] = *(const f32x4*)(F.ln_final + 16 * lane + 4 * j);
    for (int m = gw; m < M; m += NGW) {
        float s = (lane < 16) ? F.ssq3[(size_t)m * 16 + lane] : 0.f;
        s = wave_sum(s);
        const float rstd = 1.0f / sqrtf(s * (1.0f / D) + EPS);
        const v4u w0 = *(const GAS v4u*)(F.H2B + (size_t)m * D + 16 * lane), w1 = *(const GAS v4u*)(F.H2B + (size_t)m * D + 16 * lane + 8);
        GAS f32x4* o = (GAS f32x4*)(F.out + (size_t)m * D + 16 * lane);
        o[0] = (f32x4){pg8::bf_lo(w0.x), pg8::bf_hi(w0.x), pg8::bf_lo(w0.y), pg8::bf_hi(w0.y)} * rstd * gv[0];
        o[1] = (f32x4){pg8::bf_lo(w0.z), pg8::bf_hi(w0.z), pg8::bf_lo(w0.w), pg8::bf_hi(w0.w)} * rstd * gv[1];
        o[2] = (f32x4){pg8::bf_lo(w1.x), pg8::bf_hi(w1.x), pg8::bf_lo(w1.y), pg8::bf_hi(w1.y)} * rstd * gv[2];
        o[3] = (f32x4){pg8::bf_lo(w1.z), pg8::bf_hi(w1.z), pg8::bf_lo(w1.w), pg8::bf_hi(w1.w)} * rstd * gv[3];
    }
}

struct Args { const float* in[18]; float* out; unsigned char* ws; int ph_lo, ph_hi, li, pad; };
__global__ void __launch_bounds__(NWAVES * 64, 2) mk_fwd(Args args) {
    extern __shared__ __attribute__((aligned(16))) unsigned char lds[];
    Frame F;
    F.lds = (LAS unsigned char*)lds;
    F.MISC = (volatile LAS unsigned*)(F.lds + MISC_OFF);
    F.wave = __builtin_amdgcn_readfirstlane((int)threadIdx.x >> 6);
    F.G = gridDim.x; { const int bx = blockIdx.x; F.vcu = (F.G % 8 == 0) ? (bx % 8) * (F.G / 8) + bx / 8 : bx; }
    unsigned char* ws = args.ws;
    F.ctl = (gu32*)(ws + WS_CTL);
    F.x = args.in[0]; F.p = args.in[1]; F.ln_mix = args.in[2]; F.w_in = args.in[3]; F.w_gate_lr = args.in[4]; F.b_gate = args.in[5]; F.gla_norm = args.in[6];
    F.w_pool = args.in[7]; F.pool_scale = args.in[8]; F.w_out = args.in[9]; F.ln_ffn = args.in[10]; F.w_gate = args.in[11]; F.w_up = args.in[12]; F.w_down = args.in[13];
    F.ln_ple = args.in[14]; F.w_pg = args.in[15]; F.w_pp = args.in[16]; F.ln_final = args.in[17]; F.out = args.out;
    F.Win_t = (bf16*)(ws + WS_WIN); F.Wout_t = (bf16*)(ws + WS_WOUT); F.Wgu_t = (bf16*)(ws + WS_WGU); F.Wd_t = (bf16*)(ws + WS_WD); F.Wpg_t = (bf16*)(ws + WS_WPG); F.Wpp_t = (bf16*)(ws + WS_WPP);
    F.zf = (float*)(ws + WS_ZF); F.ssx = (float*)(ws + WS_SSX); F.glrb = (bf16*)(ws + WS_GLRB); F.rsx = (float*)(ws + WS_RSX); F.glr = (float*)(ws + WS_GLR); F.ssq1 = (float*)(ws + WS_SSQ1); F.ssq2 = (float*)(ws + WS_SSQ2); F.ssq3 = (float*)(ws + WS_SSQ3);
    F.XB = (bf16*)(ws + WS_XB); F.Z = (bf16*)(ws + WS_Z); F.ACT = (bf16*)(ws + WS_ACT); F.A2 = (bf16*)(ws + WS_A2); F.H2B = (bf16*)(ws + WS_H2B);
    F.H1B = (bf16*)(ws + WS_H1B); F.PP = (bf16*)(ws + WS_PP); F.PB = (bf16*)(ws + WS_PB);
    for (int u = threadIdx.x; u < (LDS_BYTES - LDSCTL_OFF) / 4; u += NWAVES * 64) ((LAS unsigned*)(F.lds + LDSCTL_OFF))[u] = 0u;
    __syncthreads();
    XcdBarrier bar; bar.bar = (unsigned*)(F.ctl + CW_BAR); bar.x = 0; bar.st = nullptr;
    if (N_LAUNCHES == 1) bar = xcd_barrier_post((unsigned*)(F.ctl + CW_BAR), F.MISC + 8);
#define GRID_BAR(seam) do { if (N_LAUNCHES != 1) { if (threadIdx.x == 0) __hip_atomic_store(F.ctl + CW_TMO, 0xBADBA0u | (unsigned)(seam), RLX_AGENT); } else { xcd_barrier(bar); } } while (0)
    const int lo = args.ph_lo, hi = args.ph_hi;
#ifndef PHASE_MASK
#define PHASE_MASK 0xff
#endif
#define IN(k) (((PHASE_MASK >> (k)) & 1) && lo <= (k) && (k) < hi)
#ifndef TIMING_A
#define TIMING_A -1
#define TIMING_B -1
#endif
    constexpr int CW_TS = 230000;
#define STAMP(k) do { if (TIMING_A >= 0 && blockIdx.x == 0 && threadIdx.x == 0) { const unsigned long long t_ = __builtin_amdgcn_s_memrealtime(); __hip_atomic_store(F.ctl + CW_TS + 2 * (k), (unsigned)t_, RLX_AGENT); __hip_atomic_store(F.ctl + CW_TS + 2 * (k) + 1, (unsigned)(t_ >> 32), RLX_AGENT); } } while (0)
    STAMP(0);
#define BOTH(k) (IN(k) && IN((k) + 1))

    if (IN(0)) { p0_prologue(F); if (BOTH(0)) GRID_BAR(0); STAMP(1); }

    if (IN(1)) {
        pg8::Gemm g{F.XB, F.Win_t, M, NZ, D}; pg8::StaticOrder S; S.init(M, NZ, F.G, (int)blockIdx.x);
        pg8::EpiScaleBf16 E{F.Z, NZ, F.rsx};
        pg8::gemm_phase<pg8::EpiScaleBf16, pg8::StaticOrder, PG8_ALIGN, PG8_SP2>(F.lds + RING_OFF, g, S, E);
        if (BOTH(1)) GRID_BAR(1); STAMP(2);
    }

    if (IN(2)) {
        if ((int)blockIdx.x < 64 || F.G < 128) { for (int bh = blockIdx.x; bh < BATCH * NH; bh += F.G) {
#ifdef GLA_SIMPLE
                p2_gla_simple(F, bh);
#else
                p2_gla_chunked(F, bh);
#endif
                p2_gla_fix(F, bh);
#if DIAG_MODE
                __syncthreads(); p2_gla_simple_t<true>(F, bh);
#endif
            } }
        if (F.G < 128) p2_pool_simple(F, (int)blockIdx.x * NWAVES * 64 + my_tid(), F.G * NWAVES * 64);
        else if ((int)blockIdx.x >= 64) p2_pool_simple(F, ((int)blockIdx.x - 64) * NWAVES * 64 + my_tid(), (F.G - 64) * NWAVES * 64);
        if (BOTH(2)) GRID_BAR(2); STAMP(3);
    }

    if (IN(3)) {
        pg8::Gemm g{F.A2, F.Wout_t, M, D, D}; pg8::StaticOrder S; S.init(M, D, F.G, (int)blockIdx.x);
        pg8::EpiResid<false> E{F.x, F.H1B, F.ssq1};
        pg8::gemm_phase<pg8::EpiResid<false>, pg8::StaticOrder, PG8_ALIGN, PG8_SP2>(F.lds + RING_OFF, g, S, E);
        if (BOTH(3)) GRID_BAR(3); STAMP(4);
    }

    if (IN(4)) {
        pg8::Gemm g{F.H1B, F.Wgu_t, M, NGU, D}; pg8::StaticOrder S; S.init(M, NGU, F.G, (int)blockIdx.x);
        pg8::EpiSwiglu E{F.ACT, FF, F.ssq1};
        pg8::gemm_phase<pg8::EpiSwiglu, pg8::StaticOrder, PG8_ALIGN, PG8_SP2>(F.lds + RING_OFF, g, S, E);
        if (BOTH(4)) GRID_BAR(4); STAMP(5);
    }

    if (IN(5)) {
        pg8::Gemm g{F.ACT, F.Wd_t, M, D, FF}; pg8::StaticOrder S; S.init(M, D, F.G, (int)blockIdx.x);
        pg8::EpiResid<true> E{F.H1B, F.H2B, F.ssq2};
        pg8::gemm_phase<pg8::EpiResid<true>, pg8::StaticOrder, PG8_ALIGN, PG8_SP2>(F.lds + RING_OFF, g, S, E);
        if (BOTH(5)) GRID_BAR(5); STAMP(6);
    }

    if (IN(6)) {
#ifndef SKIP_PP
        { pg8::Gemm g{F.PB, F.Wpp_t, M, D, DPLE}; pg8::StaticOrder S; S.init(M, D, F.G, (int)blockIdx.x);
          pg8::EpiPlainBf16 E{F.PP, D};
          pg8::gemm_phase<pg8::EpiPlainBf16, pg8::StaticOrder, PG8_ALIGN, PG8_SP2>(F.lds + RING_OFF, g, S, E); }
#endif
#ifndef SKIP_PLE
        { pg8::Gemm g{F.H2B, F.Wpg_t, M, D, D}; pg8::StaticOrder S; S.init(M, D, F.G, (int)blockIdx.x);
          pg8::EpiPle E{F.H2B, F.PP, F.ssq2, F.ssq3};
          pg8::gemm_phase<pg8::EpiPle, pg8::StaticOrder, PG8_ALIGN, PG8_SP2>(F.lds + RING_OFF, g, S, E); }
#endif
        if (BOTH(6)) GRID_BAR(6); STAMP(7);
    }

    if (IN(7)) { p7_final(F);
#if TIMING_A >= 0
        GRID_BAR(7); STAMP(8);
        if (blockIdx.x == 0) {
            __syncthreads();
            const unsigned long long ta0 = ((unsigned long long)F.ctl[CW_TS + 2 * TIMING_A + 1] << 32) | F.ctl[CW_TS + 2 * TIMING_A], ta1 = ((unsigned long long)F.ctl[CW_TS + 2 * TIMING_A + 3] << 32) | F.ctl[CW_TS + 2 * TIMING_A + 2];
            const unsigned long long tb0 = ((unsigned long long)F.ctl[CW_TS + 2 * TIMING_B + 1] << 32) | F.ctl[CW_TS + 2 * TIMING_B], tb1 = ((unsigned long long)F.ctl[CW_TS + 2 * TIMING_B + 3] << 32) | F.ctl[CW_TS + 2 * TIMING_B + 2];
            const float da = (float)(ta1 - ta0) * 0.01f, db = (float)(tb1 - tb0) * 0.01f;
            for (int i = threadIdx.x; i < 1024 * 1024; i += NWAVES * 64) F.out[(size_t)1024 * 1024 + i] = db;
            if (threadIdx.x == 0) F.out[1] = 10.f * da;
        }
#endif
#if DIAG_MODE
        if (blockIdx.x == 0 && threadIdx.x == 0) {
            float best = 0.f; int arg = 0;
            for (int c = 0; c < 128; ++c) { const float v = __uint_as_float(__hip_atomic_load((unsigned*)(F.ctl + CW_DIAG) + c, RLX_AGENT)); if (v > best) { best = v; arg = c; } }
            asm volatile("s_waitcnt vmcnt(0)" ::: "memory");
            F.out[1] = (DIAG_MODE == 5) ? (best * 10000.f) : (best < 0.02f ? 500.f : 100.f * (float)(10 + arg));
        }
#endif
    }
#undef IN
#undef BOTH
}

extern "C" void kernel_launch(void* const* d_in, const int* in_sizes, int n_in, void* d_out, int out_size, void* d_ws, size_t ws_size, hipStream_t stream) {
    static int grid = 0;
    if (grid == 0) {
        if (n_in != 18 || in_sizes[0] != M * D || out_size != M * D || ws_size < WS_END) { fprintf(stderr, "kernel_launch: unexpected shapes (n_in %d, in0 %d, out %d, ws %zu); nothing launched\n", n_in, n_in > 0 ? in_sizes[0] : -1, out_size, ws_size); grid = -1; return; }
        int dev = 0, cus = 0, per_cu = 0;
        if (hipGetDevice(&dev) != hipSuccess || hipDeviceGetAttribute(&cus, hipDeviceAttributeMultiprocessorCount, dev) != hipSuccess) { fprintf(stderr, "kernel_launch: device query failed\n"); grid = -1; return; }
        if (hipFuncSetAttribute((const void*)mk_fwd, hipFuncAttributeMaxDynamicSharedMemorySize, LDS_BYTES) != hipSuccess) { fprintf(stderr, "kernel_launch: hipFuncSetAttribute failed\n"); grid = -1; return; }
        if (hipOccupancyMaxActiveBlocksPerMultiprocessor(&per_cu, (const void*)mk_fwd, NWAVES * 64, LDS_BYTES) != hipSuccess || per_cu < 1)
            fprintf(stderr, "kernel_launch: note: occupancy query reports %d workgroups per CU\n", per_cu);
        (void)hipGetLastError();
        grid = cus;
    }
    if (grid < 0) return;
    if (hipMemsetAsync((char*)d_ws + WS_CTL, 0, CTL_ZERO_BYTES, stream) != hipSuccess) { fprintf(stderr, "kernel_launch: hipMemsetAsync failed\n"); return; }
    Args a{};
    for (int i = 0; i < 18; ++i) a.in[i] = (const float*)d_in[i];
    a.out = (float*)d_out; a.ws = (unsigned char*)d_ws;
    for (int li = 0; li < N_LAUNCHES; ++li) {
        a.ph_lo = (N_LAUNCHES == 1) ? 0 : li; a.ph_hi = (N_LAUNCHES == 1) ? N_PHASES : li + 1; a.li = li;
        hipLaunchKernelGGL(mk_fwd, dim3(grid), dim3(NWAVES * 64), LDS_BYTES, stream, a);
        const hipError_t le = hipPeekAtLastError();
        if (le != hipSuccess) { fprintf(stderr, "kernel_launch: launch %d failed: %s\n", li, hipGetErrorName(le)); break; }
    }
}
```
